# Optimizing an MI355X kernel written in HIP

```python
import jax, jax.numpy as jnp
from jax import lax
import numpy as np

D_MODEL = 1024
BATCH = 16
SEQ = 256
DEPTH = 4
DEC_BATCH = 2
DEC_SEQ = 4096
PAST_LEN = 256

GRID_W = 64
N_MIXERS = 2
N_FOURIER_LAYERS = (DEPTH + 1) // 2
N_NA_LAYERS = DEPTH // 2
N_HEADS = 16
HEAD_DIM = D_MODEL // N_HEADS
N_FOURIER_GROUPS = 8
FOURIER_GROUP_DIM = D_MODEL // N_FOURIER_GROUPS
WIN_ROWS_MAX = 8
WIN_COLS = 16
D_FF = 2816
N_MOD = 9
RMS_EPS = 1e-6

kernel_name = "hybrid_fnet_natten_macaron_step"


def _rmsnorm(x, g):
    x32 = x.astype(jnp.float32)
    y = x32 * lax.rsqrt(jnp.mean(x32 * x32, axis=-1, keepdims=True) + RMS_EPS)
    return (y * g.astype(jnp.float32)).astype(x.dtype)


def _modulation(cond, w_mod, b_mod):
    m = jax.nn.silu(cond) @ w_mod + b_mod
    return m.reshape(cond.shape[0], N_MOD, D_MODEL)


def _modulated_prenorm(x, g, m, k):
    return _rmsnorm(x, g) * (1 + m[:, 3 * k + 1, None]) + m[:, 3 * k, None]


def _swiglu(h, w1, w2):
    gate, up = jnp.split(h @ w1, 2, axis=-1)
    return (jax.nn.silu(gate) * up) @ w2


def _half_ffn(x, m, k, g_pre, g_post, w1, w2):
    h = _modulated_prenorm(x, g_pre, m, k)
    return x + 0.5 * m[:, 3 * k + 2, None] * _rmsnorm(_swiglu(h, w1, w2), g_post)


def _fourier_mix(h, w_in, w_out):
    b, s, _ = h.shape
    u = (h @ w_in).reshape(b, s, N_FOURIER_GROUPS, FOURIER_GROUP_DIM)
    f = jnp.fft.fft2(u.astype(jnp.float32), axes=(1, 3), norm="ortho").real
    return f.astype(h.dtype).reshape(b, s, D_MODEL) @ w_out


def _split_heads(t):
    b, s, _ = t.shape
    return t.reshape(b, s, N_HEADS, HEAD_DIM).transpose(0, 2, 1, 3)


def _merge_heads(t):
    b, h, s, dh = t.shape
    return t.transpose(0, 2, 1, 3).reshape(b, s, h * dh)


def _qkv(h, w_qkv):
    q, k, v = jnp.split(h @ w_qkv, 3, axis=-1)
    return _split_heads(q) * (HEAD_DIM ** -0.5), _split_heads(k), _split_heads(v)


def _context_attention(q, k, v):
    s = jnp.einsum('bhqd,bhkd->bhqk', q, k).astype(jnp.float32)
    p = jax.nn.softmax(s, axis=-1).astype(v.dtype)
    return jnp.einsum('bhqk,bhkd->bhqd', p, v)


def _neighbourhood_attention(q, k, v, k_ctx, v_ctx, rpb, rows):
    b, h, s, dh = q.shape
    kh = min(WIN_ROWS_MAX, rows)
    qg = q.reshape(b, h, rows, GRID_W, dh)
    kg = k.reshape(b, h, rows, GRID_W, dh)
    vg = v.reshape(b, h, rows, GRID_W, dh)
    cols = jnp.arange(GRID_W)
    col_start = jnp.clip(cols - WIN_COLS // 2, 0, GRID_W - WIN_COLS)
    col_idx = col_start[:, None] + jnp.arange(WIN_COLS)[None, :]
    col_off = col_idx - cols[:, None] + (WIN_COLS - 1)
    n_loc = kh * WIN_COLS

    def row_block(r):
        rs = jnp.clip(r - kh // 2, 0, rows - kh)
        q_r = lax.dynamic_index_in_dim(qg, r, axis=2, keepdims=False)
        k_rows = lax.dynamic_slice_in_dim(kg, rs, kh, axis=2)
        v_rows = lax.dynamic_slice_in_dim(vg, rs, kh, axis=2)
        k_win = jnp.take(k_rows, col_idx, axis=3)
        v_win = jnp.take(v_rows, col_idx, axis=3)
        bias_rows = lax.dynamic_slice_in_dim(rpb, rs - r + (WIN_ROWS_MAX - 1), kh, axis=1)
        bias = jnp.take(bias_rows, col_off, axis=2).transpose(0, 2, 1, 3)
        s_loc = jnp.einsum('bhwd,bhiwjd->bhwij', q_r, k_win).astype(jnp.float32) + bias[None].astype(jnp.float32)
        s_ctx = jnp.einsum('bhwd,bhpd->bhwp', q_r, k_ctx).astype(jnp.float32)
        logits = jnp.concatenate([s_loc.reshape(b, h, GRID_W, n_loc), s_ctx], axis=-1)
        p = jax.nn.softmax(logits, axis=-1).astype(v.dtype)
        p_loc = p[..., :n_loc].reshape(b, h, GRID_W, kh, WIN_COLS)
        p_ctx = p[..., n_loc:]
        return (jnp.einsum('bhwij,bhiwjd->bhwd', p_loc, v_win)
                + jnp.einsum('bhwp,bhpd->bhwd', p_ctx, v_ctx))

    o = lax.map(row_block, jnp.arange(rows))
    return o.transpose(1, 0, 3, 2, 4).reshape(b, s, h * dh)


def setup_inputs(seed: int = 0) -> dict:
    key = jax.random.key(seed)
    ks = jax.random.split(key, 18)
    f32 = jnp.float32

    def nrm(k, shape, scale):
        return jax.random.normal(k, shape, f32) * scale

    return {
        "x_prompt": nrm(ks[0], (BATCH, SEQ, D_MODEL), 1.0),
        "x_sample": nrm(ks[1], (DEC_BATCH, DEC_SEQ, D_MODEL), 1.0),
        "cache_k": nrm(ks[2], (DEC_BATCH, N_NA_LAYERS, N_HEADS, PAST_LEN, HEAD_DIM), 1.0),
        "cache_v": nrm(ks[3], (DEC_BATCH, N_NA_LAYERS, N_HEADS, PAST_LEN, HEAD_DIM), 1.0),
        "c": nrm(ks[4], (DEC_BATCH, D_MODEL), 1.0),
        "c_ctx": nrm(ks[5], (D_MODEL,), 1.0),
        "w_mod": nrm(ks[6], (DEPTH, D_MODEL, N_MOD * D_MODEL), 0.5 * D_MODEL ** -0.5),
        "b_mod": nrm(ks[7], (DEPTH, N_MOD * D_MODEL), 0.01),
        "norm_pre": 1.0 + nrm(ks[8], (DEPTH, 3, D_MODEL), 0.02),
        "norm_post": 1.0 + nrm(ks[9], (DEPTH, 3, D_MODEL), 0.02),
        "ffn_w1": nrm(ks[10], (DEPTH, 2, D_MODEL, 2 * D_FF), D_MODEL ** -0.5),
        "ffn_w2": nrm(ks[11], (DEPTH, 2, D_FF, D_MODEL), D_FF ** -0.5),
        "four_w_in": nrm(ks[12], (N_FOURIER_LAYERS, D_MODEL, D_MODEL), D_MODEL ** -0.5),
        "four_w_out": nrm(ks[13], (N_FOURIER_LAYERS, D_MODEL, D_MODEL), D_MODEL ** -0.5),
        "na_w_qkv": nrm(ks[14], (N_NA_LAYERS, D_MODEL, 3 * D_MODEL), D_MODEL ** -0.5),
        "na_w_out": nrm(ks[15], (N_NA_LAYERS, D_MODEL, D_MODEL), D_MODEL ** -0.5),
        "na_rpb": nrm(ks[16], (N_NA_LAYERS, N_HEADS, 2 * WIN_ROWS_MAX - 1, 2 * WIN_COLS - 1), 0.02),
    }


def reference(x_prompt, x_sample, cache_k, cache_v, c, c_ctx, w_mod, b_mod, norm_pre, norm_post,
              ffn_w1, ffn_w2, four_w_in, four_w_out, na_w_qkv, na_w_out, na_rpb):
    rows = x_sample.shape[1] // GRID_W
    xp = x_prompt
    xs = x_sample
    new_k = []
    new_v = []
    for i in range(DEPTH):
        m_ctx = _modulation(c_ctx[None, :], w_mod[i], b_mod[i])
        m_lat = _modulation(c, w_mod[i], b_mod[i])
        xp = _half_ffn(xp, m_ctx, 0, norm_pre[i, 0], norm_post[i, 0], ffn_w1[i, 0], ffn_w2[i, 0])
        xs = _half_ffn(xs, m_lat, 0, norm_pre[i, 0], norm_post[i, 0], ffn_w1[i, 0], ffn_w2[i, 0])
        hp = _modulated_prenorm(xp, norm_pre[i, 1], m_ctx, 1)
        hs = _modulated_prenorm(xs, norm_pre[i, 1], m_lat, 1)
        j = i // N_MIXERS
        if i % N_MIXERS == 0:
            yp = _fourier_mix(hp, four_w_in[j], four_w_out[j])
            ys = _fourier_mix(hs, four_w_in[j], four_w_out[j])
        else:
            qp, kp, vp = _qkv(hp, na_w_qkv[j])
            new_k.append(kp)
            new_v.append(vp)
            yp = _merge_heads(_context_attention(qp, kp, vp)) @ na_w_out[j]
            qs, ks_, vs = _qkv(hs, na_w_qkv[j])
            ys = _neighbourhood_attention(qs, ks_, vs, cache_k[:, j], cache_v[:, j], na_rpb[j], rows) @ na_w_out[j]
        xp = xp + m_ctx[:, 5, None] * _rmsnorm(yp, norm_post[i, 1])
        xs = xs + m_lat[:, 5, None] * _rmsnorm(ys, norm_post[i, 1])
        xp = _half_ffn(xp, m_ctx, 2, norm_pre[i, 2], norm_post[i, 2], ffn_w1[i, 1], ffn_w2[i, 1])
        xs = _half_ffn(xs, m_lat, 2, norm_pre[i, 2], norm_post[i, 2], ffn_w1[i, 1], ffn_w2[i, 1])
    new_cache_k = jnp.stack(new_k, axis=1)
    new_cache_v = jnp.stack(new_v, axis=1)
    return (xp, xs, new_cache_k, new_cache_v)
```

```cpp
#include <hip/hip_runtime.h>
#include <hip/hip_cooperative_groups.h>
#include <cstdio>
#include <cstdint>
namespace cg = cooperative_groups;
namespace pg8 {
#define PG8_LAS __attribute__((address_space(3)))
typedef unsigned short bf16_t;
typedef short bf16x8 __attribute__((ext_vector_type(8)));
typedef float f32x4 __attribute__((ext_vector_type(4)));
typedef unsigned u32x4 __attribute__((ext_vector_type(4)));
constexpr int BM = 256, BK = 64, HALF = 128, HTB = HALF * BK * 2  , STAGE_BYTES = 8 * HTB, NXCD = 8, WGM = 8;

__host__ __device__ __forceinline__ int lds_byte(int r, int c) { const int st = (r >> 4) * 2 + (c >> 5), rr = r & 15, cc = c & 31, ob = rr * 64 + cc * 2; return st * 1024 + (ob ^ (((ob >> 9) & 1) << 5)); }
__host__ __device__ __forceinline__ void stage_rc(int b, int& R, int& C) { const int st = b / 1024, sb = b % 1024, swz = sb ^ (((sb >> 9) & 1) << 5); R = (st >> 1) * 16 + swz / 64; C = (st & 1) * 32 + (swz % 64) / 2; }
__host__ __device__ __forceinline__ int perm32(int rho) { const int n = rho >> 4, i = rho & 15; return 8 * (i >> 2) + 4 * n + (i & 3); }

struct Unit { int pm, pn, z; unsigned offA, offB; };
struct Gemm { const bf16_t* A; const bf16_t* Bt; int M, N, K; };


template <class Epi, class Sched, bool ALIGN_EPI = false, bool SP2 = false>
__device__ __forceinline__ void gemm_phase(PG8_LAS unsigned char* lds, const Gemm g, const Sched& S, const Epi& E) {
    int tid = threadIdx.x; asm volatile("" : "+v"(tid));
    const int wid = __builtin_amdgcn_readfirstlane(tid >> 6), lane = tid & 63, wr = wid >> 2, wc = wid & 3, fr = lane & 15, fq = lane >> 4;
    const int K = g.K, nt = K / BK;
    unsigned voffA[2], voffB[2];
#pragma unroll
    for (int i = 0; i < 2; ++i) { int R, C; stage_rc(tid * 16 + i * 8192, R, C); const int Rb = Epi::PERM ? ((R & ~31) + perm32(R & 31)) : R;
        voffA[i] = (unsigned)(R * K + C) * 2u; voffB[i] = (unsigned)(Rb * K + C) * 2u; }
    const size_t kstep = (size_t)(BK * 2);
    const size_t hstep = (size_t)HALF * K * 2;
    const size_t tstep = 2 * hstep;
    const unsigned ldsw = (unsigned)wid * 1024u;
    const int aoff = lds_byte(wr * 64 + fr, fq * 8), boff = lds_byte(wc * 32 + fr, fq * 8);
#define PG8_SA(b, h) (((b) * 2 + (h)) * HTB)
#define PG8_SB(b, h) ((4 + (b) * 2 + (h)) * HTB)
#define PG8_STAGE(bufoff, gbase, voff) do { _Pragma("unroll") for (int _i = 0; _i < 2; ++_i) \
        __builtin_amdgcn_global_load_lds((const unsigned*)((const char*)(gbase) + (voff)[_i]), (PG8_LAS unsigned*)(lds + (bufoff) + ldsw + _i * 8192), 16, 0, 0); } while (0)
#define PG8_LDA(dst, b, h) do { _Pragma("unroll") for (int m = 0; m < 4; ++m) _Pragma("unroll") for (int k = 0; k < 2; ++k) dst[m][k] = *(const PG8_LAS bf16x8*)(lds + PG8_SA(b, h) + aoff + m * 2048 + k * 1024); } while (0)
#define PG8_LDB(dst, b, h) do { _Pragma("unroll") for (int n = 0; n < 2; ++n) _Pragma("unroll") for (int k = 0; k < 2; ++k) dst[n][k] = *(const PG8_LAS bf16x8*)(lds + PG8_SB(b, h) + boff + n * 2048 + k * 1024); } while (0)
#define PG8_MMA(ai, bj, At, Bt) do { __builtin_amdgcn_s_setprio(1); _Pragma("unroll") for (int m = 0; m < 4; ++m) _Pragma("unroll") for (int n = 0; n < 2; ++n) _Pragma("unroll") for (int k = 0; k < 2; ++k) \
        acc[ai][bj][m][n] = __builtin_amdgcn_mfma_f32_16x16x32_bf16(Bt[n][k], At[m][k], acc[ai][bj][m][n], 0, 0, 0); __builtin_amdgcn_s_setprio(0); } while (0)
#define PG8_WAIT_V(n) asm volatile("s_waitcnt vmcnt(" #n ")" ::: "memory")
#define PG8_WAIT_L(n) asm volatile("s_waitcnt lgkmcnt(" #n ")" ::: "memory")
#define PG8_BAR __builtin_amdgcn_s_barrier()
#define PG8_SCHED __builtin_amdgcn_sched_barrier(0)
    Unit cur, nxt; int ui = 0;
    if (!S.next(0, cur)) return;
    f32x4 acc[2][2][4][2];
#pragma unroll
    for (int a = 0; a < 2; ++a)
#pragma unroll
        for (int b = 0; b < 2; ++b)
#pragma unroll
            for (int m = 0; m < 4; ++m)
#pragma unroll
                for (int n = 0; n < 2; ++n) acc[a][b][m][n] = (f32x4){0.f, 0.f, 0.f, 0.f};
    bf16x8 At[4][2], B0[2][2], B1[2][2];
    const char* cA = (const char*)g.A + cur.offA; const char* cB = (const char*)g.Bt + cur.offB;
    S.a_ready(cur);
    if constexpr (SP2) {
        PG8_STAGE(PG8_SB(0, 0), cB, voffB); PG8_STAGE(PG8_SB(0, 1), cB + hstep, voffB); PG8_STAGE(PG8_SA(0, 0), cA, voffA); PG8_STAGE(PG8_SA(0, 1), cA + hstep, voffA);
        if (wr == 1) PG8_BAR;
        PG8_WAIT_V(2); PG8_BAR;
        PG8_STAGE(PG8_SB(1, 0), cB + kstep, voffB); PG8_STAGE(PG8_SA(1, 0), cA + kstep, voffA); PG8_STAGE(PG8_SB(1, 1), cB + hstep + kstep, voffB);
        PG8_WAIT_V(6); PG8_BAR;
    } else {
        PG8_STAGE(PG8_SB(0, 0), cB, voffB); PG8_STAGE(PG8_SA(0, 0), cA, voffA); PG8_STAGE(PG8_SB(0, 1), cB + hstep, voffB); PG8_STAGE(PG8_SA(0, 1), cA + hstep, voffA);
        if (wr == 1) PG8_BAR;
        PG8_WAIT_V(4); PG8_BAR;
        PG8_STAGE(PG8_SB(1, 0), cB + kstep, voffB); PG8_STAGE(PG8_SA(1, 0), cA + kstep, voffA); PG8_STAGE(PG8_SB(1, 1), cB + hstep + kstep, voffB);
        PG8_WAIT_V(6); PG8_BAR;
    }
    for (;;) {
        const bool has_next = S.next(ui + 1, nxt);
        const char* nA = has_next ? (const char*)g.A + nxt.offA : cA; const char* nB = has_next ? (const char*)g.Bt + nxt.offB : cB;
        for (int t = 0; t < nt; t += 2) {
            const bool last = (t == nt - 2);
            const char* a1 = cA + (size_t)(t + 1) * kstep;
            const char* a2 = last ? nA : cA + (size_t)(t + 2) * kstep; const char* b2 = last ? nB : cB + (size_t)(t + 2) * kstep;
            const char* a3 = a2 + kstep; const char* b3 = b2 + kstep;
            if (last && has_next) S.a_ready(nxt);
            if constexpr (SP2) {
            PG8_LDB(B0, 0, 0); PG8_LDB(B1, 0, 1); PG8_SCHED; PG8_LDA(At, 0, 0); PG8_STAGE(PG8_SA(1, 1), a1 + hstep, voffA);
            PG8_WAIT_V(8); PG8_WAIT_L(0); PG8_BAR; PG8_MMA(0, 0, At, B0); PG8_MMA(0, 1, At, B1); PG8_BAR; PG8_SCHED;
            PG8_LDA(At, 0, 1); PG8_STAGE(PG8_SB(0, 0), b2, voffB); PG8_STAGE(PG8_SB(0, 1), b2 + hstep, voffB); PG8_STAGE(PG8_SA(0, 0), a2, voffA);
            PG8_WAIT_V(8); PG8_WAIT_L(0); PG8_BAR; PG8_MMA(1, 0, At, B0); PG8_MMA(1, 1, At, B1); PG8_BAR; PG8_SCHED;
            PG8_LDB(B0, 1, 0); PG8_LDB(B1, 1, 1); PG8_SCHED; PG8_LDA(At, 1, 0); PG8_STAGE(PG8_SA(0, 1), a2 + hstep, voffA);
            PG8_WAIT_V(8); PG8_WAIT_L(0); PG8_BAR; PG8_MMA(0, 0, At, B0); PG8_MMA(0, 1, At, B1); PG8_BAR; PG8_SCHED;
            PG8_LDA(At, 1, 1); PG8_STAGE(PG8_SB(1, 0), b3, voffB); PG8_STAGE(PG8_SB(1, 1), b3 + hstep, voffB); PG8_STAGE(PG8_SA(1, 0), a3, voffA);
            PG8_WAIT_V(8); PG8_WAIT_L(0); PG8_BAR; PG8_MMA(1, 0, At, B0); PG8_MMA(1, 1, At, B1); PG8_BAR; PG8_SCHED;
            } else {
            PG8_LDB(B0, 0, 0); PG8_SCHED; PG8_LDA(At, 0, 0); PG8_STAGE(PG8_SA(1, 1), a1 + hstep, voffA);
            PG8_WAIT_L(8); PG8_BAR; PG8_WAIT_L(0); PG8_MMA(0, 0, At, B0); PG8_BAR; PG8_SCHED;
            PG8_LDB(B1, 0, 1); PG8_STAGE(PG8_SB(0, 0), b2, voffB);
            PG8_BAR; PG8_WAIT_L(0); PG8_MMA(0, 1, At, B1); PG8_BAR;
            PG8_LDA(At, 0, 1); PG8_STAGE(PG8_SA(0, 0), a2, voffA);
            PG8_BAR; PG8_WAIT_L(0); PG8_MMA(1, 0, At, B0); PG8_BAR; PG8_SCHED;
            PG8_STAGE(PG8_SB(0, 1), b2 + hstep, voffB);
            PG8_WAIT_V(6); PG8_BAR; PG8_MMA(1, 1, At, B1); PG8_BAR;
            PG8_LDB(B0, 1, 0); PG8_SCHED; PG8_LDA(At, 1, 0); PG8_STAGE(PG8_SA(0, 1), a2 + hstep, voffA);
            PG8_WAIT_L(8); PG8_BAR; PG8_WAIT_L(0); PG8_MMA(0, 0, At, B0); PG8_BAR; PG8_SCHED;
            PG8_LDB(B1, 1, 1); PG8_STAGE(PG8_SB(1, 0), b3, voffB);
            PG8_BAR; PG8_WAIT_L(0); PG8_MMA(0, 1, At, B1); PG8_BAR;
            PG8_LDA(At, 1, 1); PG8_STAGE(PG8_SA(1, 0), a3, voffA);
            PG8_BAR; PG8_WAIT_L(0); PG8_MMA(1, 0, At, B0); PG8_BAR; PG8_SCHED;
            PG8_STAGE(PG8_SB(1, 1), b3 + hstep, voffB);
            PG8_WAIT_V(6); PG8_BAR; PG8_MMA(1, 1, At, B1); PG8_BAR;
            }
        }
        if constexpr (ALIGN_EPI) { if (wr == 0) PG8_BAR; }
        if constexpr (!Epi::AFTER_DRAIN) { E(acc, cur, wr, wc, fr, fq); S.done(cur); }
        if (!has_next) break;
#pragma unroll
        for (int a = 0; a < 2; ++a)
#pragma unroll
            for (int b = 0; b < 2; ++b)
#pragma unroll
                for (int m = 0; m < 4; ++m)
#pragma unroll
                    for (int n = 0; n < 2; ++n) acc[a][b][m][n] = (f32x4){0.f, 0.f, 0.f, 0.f};
        cur = nxt; cA = nA; cB = nB; ++ui;
        if constexpr (ALIGN_EPI) { if (wr == 1) PG8_BAR; }
    }
    PG8_WAIT_V(0);
    if constexpr (!ALIGN_EPI) { if (wr == 0) PG8_BAR; }
    PG8_BAR;
    if constexpr (Epi::AFTER_DRAIN) { E.fused(acc, cur, wr, wc, fr, fq, lds, wid, lane); S.done(cur); }
#undef PG8_SA
#undef PG8_SB
#undef PG8_STAGE
#undef PG8_LDA
#undef PG8_LDB
#undef PG8_MMA
#undef PG8_WAIT_V
#undef PG8_WAIT_L
#undef PG8_BAR
#undef PG8_SCHED
}
}

using pg8::bf16_t; using pg8::f32x4; using pg8::u32x4; using pg8::bf16x8; using pg8::Unit;
#define GAS __attribute__((address_space(1)))
#define LAS __attribute__((address_space(3)))
typedef unsigned u32x2 __attribute__((ext_vector_type(2)));

constexpr int D = 1024, TP = 4096, TS = 8192, T = TP + TS, FF = 2816, NL = 4;
constexpr int NWAVES = 8, NTHR = 512;
constexpr float EPS = 1e-6f;
constexpr float LOG2E = 1.4426950408889634f;
constexpr float QSCALE = 0.125f * LOG2E;

constexpr size_t MiB = 1u << 20;
constexpr size_t WS_W1T = 0;
constexpr size_t WS_W2T = 88 * MiB;
constexpr size_t WS_FINT = 132 * MiB;
constexpr size_t WS_FOUTT = 140 * MiB;
constexpr size_t WS_WQKVT = 148 * MiB;
constexpr size_t WS_WOT = 160 * MiB;
constexpr size_t WS_WINB = 164 * MiB;
constexpr size_t WS_CST = 168 * MiB;
constexpr size_t WS_DFTS = 172 * MiB;
constexpr size_t WS_DFTP = 236 * MiB;
constexpr size_t WS_MOD = 237 * MiB;
constexpr size_t WS_SMALL = 237 * MiB + 448 * 1024;
constexpr size_t WS_CK = 238 * MiB;
constexpr size_t WS_CVT = 240 * MiB;
constexpr size_t WS_H = 242 * MiB;
constexpr size_t WS_A = 266 * MiB;
constexpr size_t WS_Y = 332 * MiB;
constexpr size_t WS_MIX = 356 * MiB;
constexpr size_t WS_CTL = 452 * MiB;
constexpr size_t CTL_BYTES = 16384;
constexpr size_t WS_END = 453 * MiB;
constexpr int LDS_BYTES = 131072 + 1024;

__device__ __forceinline__ float bf2f(unsigned b) { return __builtin_bit_cast(float, b << 16); }
typedef float f32x2_t __attribute__((ext_vector_type(2)));
typedef __bf16 bf16x2_t __attribute__((ext_vector_type(2)));
__device__ __forceinline__ unsigned pk2(float lo, float hi) { const f32x2_t v = {lo, hi}; const bf16x2_t b = __builtin_convertvector(v, bf16x2_t); return __builtin_bit_cast(unsigned, b); }
__device__ __forceinline__ float wave_sum(float v) {
#pragma unroll
    for (int o = 1; o < 64; o <<= 1) v += __shfl_xor(v, o);
    return v;
}

struct Order {
    int nM, nN, nwg, total, G, c; unsigned tA, zAl, zBh, zBl;
    __device__ __forceinline__ void init(int M, int N, int K, int nZ, int G_, int c_, unsigned zAl_, unsigned zBh_, unsigned zBl_) {
        nM = M / 256; nN = N / 256; nwg = nM * nN; total = nwg * nZ; G = G_; c = c_; tA = 512u * (unsigned)K; zAl = zAl_; zBh = zBh_; zBl = zBl_; }
    __device__ __forceinline__ bool next(int i, Unit& u) const {
        const int L = i * G + c; if (L >= total) return false;
        const int z = L / nwg; int wgid = L % nwg;
        { const int q = nwg / 8, r = nwg % 8, xcd = wgid % 8, off = wgid / 8; wgid = (xcd < r ? xcd * (q + 1) : r * (q + 1) + (xcd - r) * q) + off; }
        const int nig = 8 * nN, gid = wgid / nig, fm = gid * 8, gsz = (nM - fm) < 8 ? (nM - fm) : 8;
        u.pm = fm + ((wgid % nig) % gsz); u.pn = (wgid % nig) / gsz; u.z = z;
        u.offA = (unsigned)u.pm * tA + (unsigned)(z & 1) * zAl;
        u.offB = (unsigned)u.pn * tA + (unsigned)(z >> 1) * zBh + (unsigned)(z & 1) * zBl;
        return true;
    }
    __device__ __forceinline__ void a_ready(const Unit&) const {}
    __device__ __forceinline__ void done(const Unit&) const {}
};

typedef f32x4 AccT[2][2][4][2];
__device__ __forceinline__ void store_tile_bf16(const AccT& acc, bf16_t* base, size_t ldc, int wr, int wc, int fr, int fq, float sc) {
    bf16_t* p0 = base + (size_t)(wr * 64 + fr) * ldc + wc * 32 + 8 * fq;
#pragma unroll
    for (int ai = 0; ai < 2; ++ai)
#pragma unroll
        for (int m = 0; m < 4; ++m) { bf16_t* rowp = p0 + (size_t)(ai * 128 + m * 16) * ldc;
#pragma unroll
            for (int bj = 0; bj < 2; ++bj) { const f32x4 v0 = acc[ai][bj][m][0] * sc, v1 = acc[ai][bj][m][1] * sc;
                u32x4 w; w.x = pk2(v0[0], v0[1]); w.y = pk2(v0[2], v0[3]); w.z = pk2(v1[0], v1[1]); w.w = pk2(v1[2], v1[3]);
                *(u32x4*)(rowp + bj * 128) = w; } }
}
__device__ __forceinline__ float silu_mul(float g, float u) { return g * __builtin_amdgcn_rcpf(1.f + __builtin_amdgcn_exp2f(-g * LOG2E)) * u; }

enum { EK_SWIGLU = 0, EK_Y = 1, EK_FOLD = 2, EK_UT = 3, EK_POSP = 4, EK_POSS = 5, EK_QKV = 6 };
struct EpiMulti {
    static constexpr bool PERM = true, AFTER_DRAIN = false; int kind, jl; unsigned char* ws; float* out;
    __device__ __forceinline__ void operator()(const AccT& acc, const Unit& u, int wr, int wc, int fr, int fq) const {
        if (kind == EK_SWIGLU) {
            bf16_t* p0 = (bf16_t*)(ws + WS_A) + (size_t)(u.pm * 256 + wr * 64 + fr) * FF + u.pn * 128 + wc * 32 + 8 * fq;
#pragma unroll
            for (int ai = 0; ai < 2; ++ai)
#pragma unroll
                for (int m = 0; m < 4; ++m) { const f32x4 g0 = acc[ai][0][m][0], g1 = acc[ai][0][m][1], u0 = acc[ai][1][m][0], u1 = acc[ai][1][m][1];
                    u32x4 w; w.x = pk2(silu_mul(g0[0], u0[0]), silu_mul(g0[1], u0[1])); w.y = pk2(silu_mul(g0[2], u0[2]), silu_mul(g0[3], u0[3]));
                    w.z = pk2(silu_mul(g1[0], u1[0]), silu_mul(g1[1], u1[1])); w.w = pk2(silu_mul(g1[2], u1[2]), silu_mul(g1[3], u1[3]));
                    *(u32x4*)(p0 + (size_t)(ai * 128 + m * 16) * FF) = w; }
            return;
        }
        if (kind != EK_QKV) {
            bf16_t* base; size_t ldc = 1024;
            if (kind == EK_Y) base = (bf16_t*)(ws + WS_Y) + (size_t)u.pm * 256 * 1024 + u.pn * 256;
            else if (kind == EK_FOLD) base = (bf16_t*)(ws + WS_FINT) + (size_t)u.z * 2048 * 1024 + (size_t)u.pm * 256 * 1024 + u.pn * 256;
            else if (kind == EK_UT) {
                bf16_t* UT = (bf16_t*)(ws + WS_MIX);
                if (u.pn < 16) { ldc = 256; base = UT + (size_t)u.pn * (2048 * 256) + (size_t)u.pm * 256 * 256; }
                else { const int sb = (u.pn - 16) >> 4, s0 = ((u.pn - 16) & 15) * 256; ldc = 4096; base = UT + (size_t)16 * 2048 * 256 + (size_t)sb * (2048 * 4096) + (size_t)u.pm * 256 * 4096 + s0; }
            } else {
                const int tok0 = kind == EK_POSS ? TP : 0, S = kind == EK_POSS ? 4096 : 256; ldc = 2048;
                base = (bf16_t*)(ws + WS_MIX + 48 * MiB) + (size_t)(tok0 + (u.z >> 1) * S + u.pm * 256) * 2048 + (u.z & 1) * 1024 + u.pn * 256;
            }
            store_tile_bf16(acc, base, ldc, wr, wc, fr, fq, 1.f);
            return;
        }
        const int sect = u.pn >> 2, coff = (u.pn & 3) * 256;
        if (sect == 0) { store_tile_bf16(acc, (bf16_t*)(ws + WS_MIX) + (size_t)u.pm * 256 * D + coff, D, wr, wc, fr, fq, QSCALE); return; }
        if (sect == 1) store_tile_bf16(acc, (bf16_t*)(ws + WS_MIX + 24 * MiB) + (size_t)u.pm * 256 * D + coff, D, wr, wc, fr, fq, 1.f);
        else {
            bf16_t* VT = (bf16_t*)(ws + WS_MIX + 48 * MiB);
#pragma unroll
            for (int ai = 0; ai < 2; ++ai)
#pragma unroll
                for (int m = 0; m < 4; ++m) { const int r = u.pm * 256 + ai * 128 + wr * 64 + m * 16 + fr;
#pragma unroll
                    for (int bj = 0; bj < 2; ++bj)
#pragma unroll
                        for (int n = 0; n < 2; ++n)
#pragma unroll
                            for (int e = 0; e < 4; e += 2) { const int c = coff + bj * 128 + wc * 32 + 8 * fq + 4 * n + e; const unsigned w = pk2(acc[ai][bj][m][n][e], acc[ai][bj][m][n][e + 1]);
                                VT[(size_t)c * T + r] = (bf16_t)(w & 0xffffu); VT[(size_t)(c + 1) * T + r] = (bf16_t)(w >> 16); } }
        }
        if (u.pm < 16) {
            float* dst = out + (size_t)T * D + (sect == 1 ? (size_t)0 : (size_t)16 * 2 * 16 * 256 * 64) + (size_t)(u.pm * 2 + jl) * 16 * 256 * 64;
#pragma unroll
            for (int ai = 0; ai < 2; ++ai)
#pragma unroll
                for (int m = 0; m < 4; ++m) { const int s = ai * 128 + wr * 64 + m * 16 + fr;
#pragma unroll
                    for (int bj = 0; bj < 2; ++bj) { const int c = coff + bj * 128 + wc * 32 + 8 * fq; float* p = dst + ((size_t)(c >> 6) * 256 + s) * 64 + (c & 63);
                        *(f32x4*)p = acc[ai][bj][m][0]; *(f32x4*)(p + 4) = acc[ai][bj][m][1]; } }
        }
    }
};

__device__ __forceinline__ void ew_phase(const bool FIRST, const bool LAST, const float* xin_p, const float* xin_s, float* x, const bf16_t* y, const float* modg, int gi, float coef, const float* gpost,
                                         const float* gpre, const float* modn, int si, bf16_t* h, int gw, int NGW, int lane) {
    for (int r = gw; r < T; r += NGW) {
        const int ci = r < TP ? 0 : 1 + ((r - TP) >> 12);
        f32x4 xv[4];
        if (FIRST) {
            const float* src = r < TP ? xin_p + (size_t)r * D : xin_s + (size_t)(r - TP) * D;
#pragma unroll
            for (int j = 0; j < 4; ++j) xv[j] = *(const f32x4*)(src + 256 * j + 4 * lane);
        } else {
            const float* xr = x + (size_t)r * D; const bf16_t* yr = y + (size_t)r * D;
            f32x4 yv[4]; float ss = 0.f;
#pragma unroll
            for (int j = 0; j < 4; ++j) { xv[j] = *(const f32x4*)(xr + 256 * j + 4 * lane); const u32x2 yb = *(const u32x2*)(yr + 256 * j + 4 * lane);
                yv[j] = (f32x4){bf2f(yb.x & 0xffffu), bf2f(yb.x >> 16), bf2f(yb.y & 0xffffu), bf2f(yb.y >> 16)};
                ss += (yv[j][0] * yv[j][0] + yv[j][1] * yv[j][1]) + (yv[j][2] * yv[j][2] + yv[j][3] * yv[j][3]); }
            const float ry = coef * __builtin_amdgcn_rsqf(wave_sum(ss) * (1.f / D) + EPS);
            const float* mg = modg + ci * 9216 + gi * 1024;
#pragma unroll
            for (int j = 0; j < 4; ++j) { const f32x4 g = *(const f32x4*)(mg + 256 * j + 4 * lane), gp = *(const f32x4*)(gpost + 256 * j + 4 * lane); xv[j] += ry * g * gp * yv[j]; }
        }
        float* xo = x + (size_t)r * D;
#pragma unroll
        for (int j = 0; j < 4; ++j) *(f32x4*)(xo + 256 * j + 4 * lane) = xv[j];
        if (!LAST) {
            float ss = 0.f;
#pragma unroll
            for (int j = 0; j < 4; ++j) ss += (xv[j][0] * xv[j][0] + xv[j][1] * xv[j][1]) + (xv[j][2] * xv[j][2] + xv[j][3] * xv[j][3]);
            const float rx = __builtin_amdgcn_rsqf(wave_sum(ss) * (1.f / D) + EPS);
            const float* msh = modn + ci * 9216 + si * 1024; const float* msc = msh + 1024; bf16_t* hr = h + (size_t)r * D;
#pragma unroll
            for (int j = 0; j < 4; ++j) { const f32x4 gp = *(const f32x4*)(gpre + 256 * j + 4 * lane), sh = *(const f32x4*)(msh + 256 * j + 4 * lane), sc = *(const f32x4*)(msc + 256 * j + 4 * lane);
                const f32x4 hv = xv[j] * rx * gp * (1.f + sc) + sh; u32x2 w; w.x = pk2(hv[0], hv[1]); w.y = pk2(hv[2], hv[3]); *(u32x2*)(hr + 256 * j + 4 * lane) = w; }
        }
    }
}

__device__ __forceinline__ void transpose_item(const float* W, int N, bf16_t* WT, size_t ldw, int dst_row0, int dst_col0, LAS float* scr, int k0, int n0, int lane) {
#pragma unroll 8
    for (int i = 0; i < 32; ++i) { const int kk = 2 * i + (lane >> 5); scr[kk * 33 + (lane & 31)] = W[(size_t)(k0 + kk) * N + n0 + (lane & 31)]; }
    asm volatile("s_waitcnt lgkmcnt(0)" ::: "memory");
    const int c = lane & 7;
#pragma unroll
    for (int j = 0; j < 4; ++j) { const int n = (lane >> 3) + 8 * j; const LAS float* s = scr + (8 * c) * 33 + n;
        u32x4 o; o.x = pk2(s[0 * 33], s[1 * 33]); o.y = pk2(s[2 * 33], s[3 * 33]); o.z = pk2(s[4 * 33], s[5 * 33]); o.w = pk2(s[6 * 33], s[7 * 33]);
        *(u32x4*)(WT + (size_t)(dst_row0 + n) * ldw + dst_col0 + k0 + 8 * c) = o; }
    asm volatile("s_waitcnt lgkmcnt(0)" ::: "memory");
}

struct Args { const float* in[17]; float* out; unsigned char* ws; };

__device__ __forceinline__ void prologue(const Args& a, LAS unsigned char* lds, int G, int tid, unsigned char* ws) {
    const int lane = tid & 63, wave = __builtin_amdgcn_readfirstlane(tid >> 6);
    {
        LAS float* ssc = (LAS float*)lds; LAS float* red = (LAS float*)(lds + 16384);
        const float* c = a.in[4]; const float* cctx = a.in[5];
        for (int i = tid; i < 3 * 1024; i += NTHR) { const int ci = i >> 10, k = i & 1023; const float v = ci == 0 ? cctx[k] : c[(ci - 1) * 1024 + k];
            ssc[i] = v * __builtin_amdgcn_rcpf(1.f + __builtin_amdgcn_exp2f(-v * LOG2E)); }
        __syncthreads();
        const int cg4 = tid & 31, ks = tid >> 5;
        for (int item = blockIdx.x; item < 4 * 72; item += G) {
            const int l = item / 72, jc = item % 72;
            const float* wp = a.in[6] + (size_t)l * 1024 * 9216 + (size_t)(ks * 64) * 9216 + jc * 128 + cg4 * 4;
            f32x4 a0 = {0.f, 0.f, 0.f, 0.f}, a1 = a0, a2 = a0;
#pragma unroll 8
            for (int kk = 0; kk < 64; ++kk) { const f32x4 w = *(const f32x4*)(wp + (size_t)kk * 9216); const int k = ks * 64 + kk;
                a0 += ssc[k] * w; a1 += ssc[1024 + k] * w; a2 += ssc[2048 + k] * w; }
            __syncthreads();
#pragma unroll
            for (int e = 0; e < 4; ++e) { red[(ks * 3 + 0) * 128 + cg4 * 4 + e] = a0[e]; red[(ks * 3 + 1) * 128 + cg4 * 4 + e] = a1[e]; red[(ks * 3 + 2) * 128 + cg4 * 4 + e] = a2[e]; }
            __syncthreads();
            if (tid < 384) { const int ci = tid >> 7, col = tid & 127; float s = a.in[7][l * 9216 + jc * 128 + col];
#pragma unroll
                for (int q = 0; q < 16; ++q) s += red[(q * 3 + ci) * 128 + col];
                ((float*)(ws + WS_MOD))[(l * 3 + ci) * 9216 + jc * 128 + col] = s; }
        }
        __syncthreads();
    }
    {
        LAS float* scr = (LAS float*)(lds + wave * 16384);
        const int gw = blockIdx.x * NWAVES + wave, NGW = G * NWAVES;
        constexpr int I_W1 = 8 * 2816, I_W2 = 8 * 1408, I_FO = 2 * 1024, I_QKV = 2 * 1536, I_WO = 2 * 512, I_CV = 64 * 8;
        constexpr int NITEMS = I_W1 + I_W2 + I_FO + I_QKV + I_WO + I_CV;
        for (int it = gw; it < NITEMS; it += NGW) {
            int r = it;
            if (r < I_W1) { const int mat = r / 2816, rem = r % 2816, kb = rem / 176, nb = rem % 176, n0 = nb * 32;
                const int row0 = n0 < FF ? 256 * (n0 / 128) + (n0 % 128) : 256 * ((n0 - FF) / 128) + 128 + ((n0 - FF) % 128);
                transpose_item(a.in[10] + (size_t)mat * 1024 * 5632, 5632, (bf16_t*)(ws + WS_W1T) + (size_t)mat * 5632 * 1024, 1024, row0, 0, scr, kb * 64, n0, lane); continue; } r -= I_W1;
            if (r < I_W2) { const int mat = r / 1408, rem = r % 1408, kb = rem / 32, nb = rem % 32;
                transpose_item(a.in[11] + (size_t)mat * FF * 1024, 1024, (bf16_t*)(ws + WS_W2T) + (size_t)mat * 1024 * FF, FF, nb * 32, 0, scr, kb * 64, nb * 32, lane); continue; } r -= I_W2;
            if (r < I_FO) { const int mat = r / 1024, rem = r % 1024, dup = rem / 512, rem2 = rem % 512, kb = rem2 / 32, nb = rem2 % 32;
                transpose_item(a.in[13] + (size_t)mat * 1024 * 1024, 1024, (bf16_t*)(ws + WS_FOUTT) + (size_t)mat * 1024 * 2048, 2048, nb * 32, dup * 1024, scr, kb * 64, nb * 32, lane); continue; } r -= I_FO;
            if (r < I_QKV) { const int mat = r / 1536, rem = r % 1536, kb = rem / 96, nb = rem % 96;
                transpose_item(a.in[14] + (size_t)mat * 1024 * 3072, 3072, (bf16_t*)(ws + WS_WQKVT) + (size_t)mat * 3072 * 1024, 1024, nb * 32, 0, scr, kb * 64, nb * 32, lane); continue; } r -= I_QKV;
            if (r < I_WO) { const int mat = r / 512, rem = r % 512, kb = rem / 32, nb = rem % 32;
                transpose_item(a.in[15] + (size_t)mat * 1024 * 1024, 1024, (bf16_t*)(ws + WS_WOT) + (size_t)mat * 1024 * 1024, 1024, nb * 32, 0, scr, kb * 64, nb * 32, lane); continue; } r -= I_WO;
            { const int mat = r / 8, rem = r % 8, kb = rem / 2, nb = rem % 2;
                transpose_item(a.in[3] + (size_t)mat * 256 * 64, 64, (bf16_t*)(ws + WS_CVT) + (size_t)mat * 64 * 256, 256, nb * 32, 0, scr, kb * 64, nb * 32, lane); }
        }
    }
    {
        const long gt = (long)blockIdx.x * NTHR + tid, NT = (long)G * NTHR;
        for (long i = gt; i < 12288 + 12288 + 14880; i += NT) {
            float* dst = (float*)(ws + WS_SMALL); dst[i] = i < 12288 ? a.in[8][i] : (i < 24576 ? a.in[9][i - 12288] : a.in[16][i - 24576]); }
        constexpr long E_WIN = 2L * 1024 * 1024 / 8, E_CK = 1024L * 1024 / 8, E_CST = 2048L * 1024 / 8, E_DS = 2L * 4096 * 4096 / 8, E_DP = 2L * 256 * 256 / 8;
        constexpr long NE = E_WIN + E_CK + E_CST + E_DS + E_DP;
        for (long it = gt; it < NE; it += NT) {
            long r = it; u32x4 o;
            if (r < E_WIN + E_CK) { const float* src; bf16_t* dst;
                if (r < E_WIN) { src = a.in[12] + r * 8; dst = (bf16_t*)(ws + WS_WINB) + r * 8; } else { r -= E_WIN; src = a.in[2] + r * 8; dst = (bf16_t*)(ws + WS_CK) + r * 8; }
                const f32x4 v0 = *(const f32x4*)src, v1 = *(const f32x4*)(src + 4);
                o.x = pk2(v0[0], v0[1]); o.y = pk2(v0[2], v0[3]); o.z = pk2(v1[0], v1[1]); o.w = pk2(v1[2], v1[3]); *(u32x4*)dst = o; continue; }
            r -= E_WIN + E_CK;
            if (r < E_CST) { const int mp = (int)(r >> 7), c0 = (int)(r & 127) * 8, cs = mp >> 10, n = mp & 1023, g = n >> 7, q = n & 127;
                float v[8];
#pragma unroll
                for (int e = 0; e < 8; ++e) { const int cc = (c0 & 127) + e; const float fr = (float)((cc * q) & 127) * (1.f / 128.f);
                    const float t = cs ? __builtin_amdgcn_sinf(fr) : __builtin_amdgcn_cosf(fr); v[e] = ((c0 >> 7) == g) ? t * 0.08838834764831845f : 0.f; }
                o.x = pk2(v[0], v[1]); o.y = pk2(v[2], v[3]); o.z = pk2(v[4], v[5]); o.w = pk2(v[6], v[7]); *(u32x4*)((bf16_t*)(ws + WS_CST) + r * 8) = o; continue; }
            r -= E_CST;
            if (r < E_DS) { const int mat = (int)(r >> 21), rem = (int)(r & ((1 << 21) - 1)), p = rem >> 9, s0 = (rem & 511) * 8;
                float v[8];
#pragma unroll
                for (int e = 0; e < 8; ++e) { const float fr = (float)((p * (s0 + e)) & 4095) * (1.f / 4096.f);
                    v[e] = mat ? -__builtin_amdgcn_sinf(fr) * (1.f / 64.f) : __builtin_amdgcn_cosf(fr) * (1.f / 64.f); }
                o.x = pk2(v[0], v[1]); o.y = pk2(v[2], v[3]); o.z = pk2(v[4], v[5]); o.w = pk2(v[6], v[7]); *(u32x4*)((bf16_t*)(ws + WS_DFTS) + r * 8) = o; continue; }
            r -= E_DS;
            { const int mat = (int)(r >> 13), rem = (int)(r & 8191), p = rem >> 5, s0 = (rem & 31) * 8;
                float v[8];
#pragma unroll
                for (int e = 0; e < 8; ++e) { const float fr = (float)((p * (s0 + e)) & 255) * (1.f / 256.f);
                    v[e] = mat ? -__builtin_amdgcn_sinf(fr) * (1.f / 16.f) : __builtin_amdgcn_cosf(fr) * (1.f / 16.f); }
                o.x = pk2(v[0], v[1]); o.y = pk2(v[2], v[3]); o.z = pk2(v[4], v[5]); o.w = pk2(v[6], v[7]); *(u32x4*)((bf16_t*)(ws + WS_DFTP) + r * 8) = o; }
        }
    }
}

template <bool LOCAL>
__device__ __forceinline__ void attn_chunk(f32x4 (&o)[4], float& m, float& l, const bf16x8 (&qf)[2], const bf16_t* kl, size_t kstride, const bf16_t* vl, size_t vstride,
                                           const float* rpbh, int i0, int rs, int r, int cs0, int c, int fr, int fq) {
    constexpr int RJ = LOCAL ? 64 : 32;
    f32x4 s[4];
#pragma unroll
    for (int t = 0; t < 4; ++t) { const size_t toff = (size_t)((t >> 1) * RJ + (t & 1) * 16); s[t] = (f32x4){0.f, 0.f, 0.f, 0.f};
#pragma unroll
        for (int kk = 0; kk < 2; ++kk) { const bf16x8 kf = *(const bf16x8*)(kl + toff * kstride + kk * 32); s[t] = __builtin_amdgcn_mfma_f32_16x16x32_bf16(kf, qf[kk], s[t], 0, 0, 0); } }
    if (LOCAL) {
        const int cstart = c < 8 ? 0 : (c > 56 ? 48 : c - 8);
#pragma unroll
        for (int t = 0; t < 4; ++t) { const int i = i0 + (t >> 1); const float* bp = rpbh + (rs + i - r + 7) * 31 + 15 - c;
#pragma unroll
            for (int j = 0; j < 4; ++j) { const int kc = cs0 + 16 * (t & 1) + 4 * fq + j; const bool ok = kc >= cstart && kc < cstart + 16;
                const float bias = ok ? bp[kc] : 0.f; s[t][j] = ok ? s[t][j] + bias * LOG2E : -1e30f; } }
    }
    float mx = s[0][0];
#pragma unroll
    for (int t = 0; t < 4; ++t)
#pragma unroll
        for (int j = 0; j < 4; ++j) mx = fmaxf(mx, s[t][j]);
    mx = fmaxf(mx, __shfl_xor(mx, 16)); mx = fmaxf(mx, __shfl_xor(mx, 32));
    const float mn = fmaxf(m, mx), alpha = __builtin_amdgcn_exp2f(m - mn); m = mn;
    float ls = 0.f;
#pragma unroll
    for (int t = 0; t < 4; ++t)
#pragma unroll
        for (int j = 0; j < 4; ++j) { s[t][j] = __builtin_amdgcn_exp2f(s[t][j] - mn); ls += s[t][j]; }
    l = l * alpha + ls;
#pragma unroll
    for (int j = 0; j < 4; ++j) { const float af = __shfl(alpha, 4 * fq + j);
#pragma unroll
        for (int dt = 0; dt < 4; ++dt) o[dt][j] *= af; }
#pragma unroll
    for (int kb2 = 0; kb2 < 2; ++kb2) {
        u32x4 pw; pw.x = pk2(s[2 * kb2][0], s[2 * kb2][1]); pw.y = pk2(s[2 * kb2][2], s[2 * kb2][3]); pw.z = pk2(s[2 * kb2 + 1][0], s[2 * kb2 + 1][1]); pw.w = pk2(s[2 * kb2 + 1][2], s[2 * kb2 + 1][3]);
        const bf16x8 pa = __builtin_bit_cast(bf16x8, pw);
#pragma unroll
        for (int dt = 0; dt < 4; ++dt) { const bf16_t* vp = vl + (size_t)(dt * 16) * vstride + kb2 * RJ;
            u32x4 vw; const u32x2 v0 = *(const u32x2*)vp, v1 = *(const u32x2*)(vp + 16); vw.x = v0.x; vw.y = v0.y; vw.z = v1.x; vw.w = v1.y;
            o[dt] = __builtin_amdgcn_mfma_f32_16x16x32_bf16(pa, __builtin_bit_cast(bf16x8, vw), o[dt], 0, 0, 0); }
    }
}

__device__ __forceinline__ void attn_phase(const bf16_t* Q, const bf16_t* Kb, const bf16_t* VT, const bf16_t* ck, const bf16_t* cvt, const float* rpb, bf16_t* O, int jl, int gw, int NGW, int lane) {
    const int fr = lane & 15, fq = lane >> 4;
    for (int u = gw; u < 12288; u += NGW) {
        const int k3 = u / 3, m3 = u % 3;
        f32x4 o[4]; float m = -1e30f, l = 0.f; bf16x8 qf[2];
#pragma unroll
        for (int dt = 0; dt < 4; ++dt) o[dt] = (f32x4){0.f, 0.f, 0.f, 0.f};
        int tokq0, hh;
        if (m3 < 2) {
            const int su = k3 * 2 + m3, quarter = su & 3, r = (su >> 2) & 63; hh = (su >> 8) & 15; const int b = su >> 12;
            const int c0 = quarter * 16, cs0 = c0 < 8 ? 0 : (c0 - 8 > 32 ? 32 : c0 - 8), rs = r < 4 ? 0 : (r > 60 ? 56 : r - 4);
            tokq0 = TP + b * 4096 + r * 64 + c0;
            const bf16_t* qp = Q + (size_t)(tokq0 + fr) * D + hh * 64 + fq * 8; qf[0] = *(const bf16x8*)qp; qf[1] = *(const bf16x8*)(qp + 32);
            const bf16_t* kc = ck + (size_t)((b * 2 + jl) * 16 + hh) * 256 * 64 + (size_t)fr * 64 + fq * 8;
            const bf16_t* vc = cvt + (size_t)((b * 2 + jl) * 16 + hh) * 64 * 256 + (size_t)fr * 256 + fq * 4;
            for (int ch = 0; ch < 4; ++ch) attn_chunk<false>(o, m, l, qf, kc + (size_t)ch * 64 * 64, 64, vc + ch * 64, 256, nullptr, 0, 0, 0, 0, 0, fr, fq);
            const float* rpbh = rpb + hh * 15 * 31;
            for (int ch = 0; ch < 4; ++ch) { const int tok = TP + b * 4096 + (rs + 2 * ch) * 64 + cs0;
                attn_chunk<true>(o, m, l, qf, Kb + (size_t)(tok + fr) * D + hh * 64 + fq * 8, D, VT + (size_t)(hh * 64 + fr) * T + tok + fq * 4, T, rpbh, 2 * ch, rs, r, cs0, c0 + fr, fr, fq); }
        } else {
            const int pu = k3, qt = pu & 15; hh = (pu >> 4) & 15; const int b = pu >> 8;
            tokq0 = b * 256 + qt * 16;
            const bf16_t* qp = Q + (size_t)(tokq0 + fr) * D + hh * 64 + fq * 8; qf[0] = *(const bf16x8*)qp; qf[1] = *(const bf16x8*)(qp + 32);
            for (int ch = 0; ch < 4; ++ch) { const int tok = b * 256 + ch * 64;
                attn_chunk<false>(o, m, l, qf, Kb + (size_t)(tok + fr) * D + hh * 64 + fq * 8, D, VT + (size_t)(hh * 64 + fr) * T + tok + fq * 4, T, nullptr, 0, 0, 0, 0, 0, fr, fq); }
        }
        float lt = l + __shfl_xor(l, 16); lt += __shfl_xor(lt, 32);
        const float inv = __builtin_amdgcn_rcpf(lt);
#pragma unroll
        for (int j = 0; j < 4; ++j) { const float ij = __shfl(inv, 4 * fq + j); bf16_t* op = O + (size_t)(tokq0 + 4 * fq + j) * D + hh * 64 + fr;
#pragma unroll
            for (int dt = 0; dt < 4; ++dt) op[dt * 16] = (bf16_t)(pk2(o[dt][j] * ij, 0.f) & 0xffffu); }
    }
}

#define XB_TMO      128
#define XB_XCNT(j)  (256  + 64 * (j))
#define XB_XSUB(j)  (1280 + 64 * (j))
#define XB_XGEN(j)  (2304 + 64 * (j))
#define XB_TOP      3328
#define XB_TOPGEN   3392
#define XCD_BAR_WORDS 3456
#define XB_SPIN_CAP (1u << 18)

__device__ __forceinline__ unsigned xb_ld(unsigned* p)              { return __hip_atomic_load(p, __ATOMIC_RELAXED, __HIP_MEMORY_SCOPE_AGENT); }
__device__ __forceinline__ unsigned xb_add(unsigned* p, unsigned v) { return __hip_atomic_fetch_add(p, v, __ATOMIC_RELAXED, __HIP_MEMORY_SCOPE_AGENT); }
__device__ __forceinline__ unsigned xb_xcc_id() { return (unsigned)__builtin_amdgcn_s_getreg((3 << 11) | 20) & 0xFu; }
#define XB_SPIN(cond, bar) do { unsigned _sp = 0; while (cond) { __builtin_amdgcn_s_sleep(1); \
    if ((++_sp & 255u) == 0u) { if (xb_ld(&(bar)[XB_TMO])) break; if (_sp > XB_SPIN_CAP) { atomicAdd(&(bar)[XB_TMO], 1u); break; } } } } while (0)

struct XcdBarrier {
    unsigned* bar; unsigned x;
    volatile LAS unsigned* st;
};

__device__ __forceinline__ XcdBarrier xcd_barrier_post(unsigned* bar, volatile LAS unsigned* st) {
    XcdBarrier b; b.bar = bar; b.x = xb_xcc_id(); b.st = st;
    if (threadIdx.x == 0) (void)xb_add(&bar[XB_XCNT(b.x)], 1u);
    return b;
}
__device__ __forceinline__ void xcd_barrier_complete(unsigned* bar, unsigned x, unsigned& nloc, unsigned& nx) {
    const unsigned G = gridDim.x * gridDim.y * gridDim.z;
    unsigned sum, cnt, mine, sp = 0u;
    for (;;) {
        sum = 0u; cnt = 0u; mine = 0u;
#pragma unroll
        for (unsigned j = 0; j < 16; ++j) { const unsigned c = xb_ld(&bar[XB_XCNT(j)]); sum += c; cnt += (c > 0u) ? 1u : 0u; mine = (j == x) ? c : mine; }
        if (sum == G) break;
        __builtin_amdgcn_s_sleep(1);
        if ((++sp & 255u) == 0u) { if (xb_ld(&bar[XB_TMO])) break; if (sp > XB_SPIN_CAP) { atomicAdd(&bar[XB_TMO], 1u); break; } }
    }
    nloc = mine > 0u ? mine : 1u; nx = cnt > 0u ? cnt : 1u;
}

__device__ __forceinline__ void xcd_barrier(const XcdBarrier& b) {
    asm volatile("s_waitcnt vmcnt(0)" ::: "memory");
    __syncthreads();
    if (threadIdx.x == 0) {
        unsigned* bar = b.bar;
        __builtin_amdgcn_s_waitcnt(0);
        unsigned nloc = b.st[0], nx = b.st[1];
        if (nloc == 0u) { xcd_barrier_complete(bar, b.x, nloc, nx); b.st[0] = nloc; b.st[1] = nx; }
        const unsigned old = xb_add(&bar[XB_XSUB(b.x)], 1u);
        const unsigned gen = old / nloc;
        if (old + 1u == (gen + 1u) * nloc) {
            __builtin_amdgcn_fence(__ATOMIC_RELEASE, "agent");
            asm volatile("s_waitcnt vmcnt(0)" ::: "memory");
            const unsigned og = xb_add(&bar[XB_TOP], 1u);
            const unsigned tg = og / nx;
            if (og + 1u == (tg + 1u) * nx) xb_add(&bar[XB_TOPGEN], 1u);
            else XB_SPIN(xb_ld(&bar[XB_TOPGEN]) == tg, bar);
            __builtin_amdgcn_fence(__ATOMIC_ACQUIRE, "agent");
            xb_add(&bar[XB_XGEN(b.x)], 1u);
            asm volatile("s_waitcnt vmcnt(0)" ::: "memory");
        } else {
            XB_SPIN(xb_ld(&bar[XB_XGEN(b.x)]) == gen, bar);
            __builtin_amdgcn_fence(__ATOMIC_ACQUIRE, "agent");
            asm volatile("s_waitcnt vmcnt(0)" ::: "memory");
        }
    }
    __syncthreads();
}

__global__ void __launch_bounds__(NTHR, 2) fwd_megakernel(Args a) {
    extern __shared__ __attribute__((aligned(16))) unsigned char lds_raw[];
    cg::grid_group grid = cg::this_grid();
    LAS unsigned char* lds = (LAS unsigned char*)lds_raw;
    const int G = gridDim.x, cu = blockIdx.x, NGW = G * NWAVES;
    volatile LAS unsigned* MISC = (volatile LAS unsigned*)(lds + 131072);
    if (threadIdx.x < 64) MISC[threadIdx.x] = 0u;
    __syncthreads();
    (void)xcd_barrier_post((unsigned*)(a.ws + WS_CTL), MISC + 8);
#define GRID_BAR() do { XcdBarrier bar_; bar_.bar = (unsigned*)(ws + WS_CTL); bar_.x = xb_xcc_id(); bar_.st = (volatile LAS unsigned*)(lds + 131072) + 8; xcd_barrier(bar_); } while (0)
    {
        int tid = threadIdx.x; asm volatile("" : "+v"(tid));
        unsigned char* ws = a.ws; asm volatile("" : "+s"(ws));
        const int lane = tid & 63, wave = __builtin_amdgcn_readfirstlane(tid >> 6), gw = cu * NWAVES + wave;
        prologue(a, lds, G, tid, ws);
        asm volatile("s_waitcnt vmcnt(0)" ::: "memory"); __syncthreads();
        grid.sync();
        __builtin_amdgcn_fence(__ATOMIC_ACQUIRE, "agent"); asm volatile("s_waitcnt vmcnt(0)" ::: "memory"); __syncthreads();
        ew_phase(true, false, a.in[0], a.in[1], a.out, nullptr, nullptr, 0, 0.f, nullptr, (const float*)(ws + WS_SMALL), (const float*)(ws + WS_MOD), 0, (bf16_t*)(ws + WS_H), gw, NGW, lane);
    }
    constexpr int NPH = 2 + 11 * NL;
    for (int ph = 1; ph < NPH; ++ph) {
        const int q = ph - 2, l = ph < 2 ? 0 : q / 11, k = ph < 2 ? -1 : q % 11, jl = l >> 1; const bool four = (l & 1) == 0;
        bool sync_after = ph != NPH - 1;
        int tid = threadIdx.x; asm volatile("" : "+v"(tid));
        unsigned char* ws = a.ws; asm volatile("" : "+s"(ws));
        const int lane = tid & 63, wave = __builtin_amdgcn_readfirstlane(tid >> 6), gw = cu * NWAVES + wave;
        const float* npre = (const float*)(ws + WS_SMALL); const float* npost = npre + 12288;
        if (k == 2 || k == 7 || k == 10) {
            const float* modl = (const float*)(ws + WS_MOD) + (size_t)l * 3 * 9216;
            const int kk = k == 2 ? 0 : (k == 7 ? 1 : 2); const bool last = (k == 10 && l == NL - 1);
            const float* gpre = k == 10 ? npre + ((l + 1) * 3) * D : npre + (l * 3 + kk + 1) * D;
            ew_phase(false, last, nullptr, nullptr, a.out, (const bf16_t*)(ws + WS_Y), modl, 3 * kk + 2, kk == 1 ? 1.0f : 0.5f, npost + (l * 3 + kk) * D, gpre, k == 10 ? modl + 3 * 9216 : modl, k == 10 ? 0 : 3 * kk + 3,
                     (bf16_t*)(ws + WS_H), gw, NGW, lane);
        } else if (k == 4 && !four) {
            attn_phase((const bf16_t*)(ws + WS_MIX), (const bf16_t*)(ws + WS_MIX + 24 * MiB), (const bf16_t*)(ws + WS_MIX + 48 * MiB), (const bf16_t*)(ws + WS_CK), (const bf16_t*)(ws + WS_CVT),
                       npre + 24576 + (size_t)jl * 16 * 15 * 31, (bf16_t*)(ws + WS_MIX + 72 * MiB), jl, gw, NGW, lane);
        } else if (k == 5 && !four) {
            sync_after = false;
        } else {
            const bf16_t *A, *Bt; int M = T, N = 1024, K = 1024, nZ = 1, kind = EK_Y; unsigned zAl = 0, zBh = 0, zBl = 0;
            if (k == -1) { A = (const bf16_t*)(ws + WS_CST); Bt = (const bf16_t*)(ws + WS_WINB); M = 2048; nZ = 2; zBl = 1024u * 1024u * 2u; kind = EK_FOLD; }
            else if (k == 0 || k == 8) { A = (const bf16_t*)(ws + WS_H); Bt = (const bf16_t*)(ws + WS_W1T) + (size_t)(l * 2 + (k == 8)) * 5632 * 1024; N = 5632; kind = EK_SWIGLU; }
            else if (k == 1 || k == 9) { A = (const bf16_t*)(ws + WS_A); Bt = (const bf16_t*)(ws + WS_W2T) + (size_t)(l * 2 + (k == 9)) * 1024 * FF; K = FF; }
            else if (k == 3) {
                if (four) { A = (const bf16_t*)(ws + WS_FINT) + (size_t)jl * 2048 * 1024; Bt = (const bf16_t*)(ws + WS_H); M = 2048; N = T; kind = EK_UT; }
                else { A = (const bf16_t*)(ws + WS_H); Bt = (const bf16_t*)(ws + WS_WQKVT) + (size_t)jl * 3072 * 1024; N = 3072; kind = EK_QKV; }
            } else if (k == 4) { A = (const bf16_t*)(ws + WS_DFTP); Bt = (const bf16_t*)(ws + WS_MIX); M = 256; K = 256; nZ = 32; zAl = 256u * 256u * 2u; zBh = 2048u * 256u * 2u; zBl = 1024u * 256u * 2u; kind = EK_POSP; sync_after = false; }
            else if (k == 5) { A = (const bf16_t*)(ws + WS_DFTS); Bt = (const bf16_t*)(ws + WS_MIX) + (size_t)16 * 2048 * 256; M = 4096; K = 4096; nZ = 4; zAl = 4096u * 4096u * 2u; zBh = 2048u * 4096u * 2u; zBl = 1024u * 4096u * 2u; kind = EK_POSS; }
            else {
                if (four) { A = (const bf16_t*)(ws + WS_MIX + 48 * MiB); Bt = (const bf16_t*)(ws + WS_FOUTT) + (size_t)jl * 1024 * 2048; K = 2048; }
                else { A = (const bf16_t*)(ws + WS_MIX + 72 * MiB); Bt = (const bf16_t*)(ws + WS_WOT) + (size_t)jl * 1024 * 1024; }
            }
            pg8::Gemm g{A, Bt, M, N, K}; Order S; S.init(M, N, K, nZ, G, cu, zAl, zBh, zBl);
            EpiMulti E{kind, jl, ws, a.out}; pg8::gemm_phase<EpiMulti, Order, true, true>(lds, g, S, E);
        }
        if (sync_after) GRID_BAR();
    }
}

extern "C" void kernel_launch(void* const* d_in, const int* in_sizes, int n_in, void* d_out, int out_size, void* d_ws, size_t ws_size, hipStream_t stream) {
    static int grid = 0;
    if (grid == 0) {
        if (n_in != 17 || ws_size < WS_END) { fprintf(stderr, "kernel_launch: unexpected n_in %d or ws_size %zu\n", n_in, ws_size); grid = -1; return; }
        int dev = 0, cus = 0, per_cu = 0;
        hipGetDevice(&dev); hipDeviceGetAttribute(&cus, hipDeviceAttributeMultiprocessorCount, dev);
        hipFuncSetAttribute((const void*)fwd_megakernel, hipFuncAttributeMaxDynamicSharedMemorySize, LDS_BYTES);
        hipOccupancyMaxActiveBlocksPerMultiprocessor(&per_cu, (const void*)fwd_megakernel, NTHR, LDS_BYTES);
        if (per_cu < 1) { fprintf(stderr, "kernel_launch: occupancy query says %d blocks per CU\n", per_cu); per_cu = 1; }
        (void)hipGetLastError();
        grid = cus;
    }
    if (grid < 0) return;
    if (hipMemsetAsync((char*)d_ws + WS_CTL, 0, CTL_BYTES, stream) != hipSuccess) { fprintf(stderr, "kernel_launch: memset failed\n"); return; }
    Args a{};
    for (int i = 0; i < 17; ++i) a.in[i] = (const float*)d_in[i];
    a.out = (float*)d_out; a.ws = (unsigned char*)d_ws;
    void* args[] = {&a};
    hipError_t e = hipLaunchCooperativeKernel((const void*)fwd_megakernel, dim3(grid), dim3(NTHR), args, LDS_BYTES, stream);
    if (e != hipSuccess) fprintf(stderr, "cooperative launch failed: %s (grid %d)\n", hipGetErrorString(e), grid);
}
```

```cpp
#include <hip/hip_runtime.h>
#include <hip/hip_cooperative_groups.h>
#include <cstdio>
#include <cstdint>
namespace cg = cooperative_groups;
namespace pg8 {
#define PG8_LAS __attribute__((address_space(3)))
typedef unsigned short bf16_t;
typedef short bf16x8 __attribute__((ext_vector_type(8)));
typedef float f32x4 __attribute__((ext_vector_type(4)));
typedef unsigned u32x4 __attribute__((ext_vector_type(4)));
constexpr int BM = 256, BK = 64, HALF = 128, HTB = HALF * BK * 2  , STAGE_BYTES = 8 * HTB, NXCD = 8, WGM = 8;

__host__ __device__ __forceinline__ int lds_byte(int r, int c) { const int st = (r >> 4) * 2 + (c >> 5), rr = r & 15, cc = c & 31, ob = rr * 64 + cc * 2; return st * 1024 + (ob ^ (((ob >> 9) & 1) << 5)); }
__host__ __device__ __forceinline__ void stage_rc(int b, int& R, int& C) { const int st = b / 1024, sb = b % 1024, swz = sb ^ (((sb >> 9) & 1) << 5); R = (st >> 1) * 16 + swz / 64; C = (st & 1) * 32 + (swz % 64) / 2; }
__host__ __device__ __forceinline__ int perm32(int rho) { const int n = rho >> 4, i = rho & 15; return 8 * (i >> 2) + 4 * n + (i & 3); }

struct Unit { int pm, pn, z; unsigned offA, offB; };
struct Gemm { const bf16_t* A; const bf16_t* Bt; int M, N, K; };


template <class Epi, class Sched, bool ALIGN_EPI = false, bool SP2 = false>
__device__ __forceinline__ void gemm_phase(PG8_LAS unsigned char* lds, const Gemm g, const Sched& S, const Epi& E) {
    int tid = threadIdx.x; asm volatile("" : "+v"(tid));
    const int wid = __builtin_amdgcn_readfirstlane(tid >> 6), lane = tid & 63, wr = wid >> 2, wc = wid & 3, fr = lane & 15, fq = lane >> 4;
    const int K = g.K, nt = K / BK;
    unsigned voffA[2], voffB[2];
#pragma unroll
    for (int i = 0; i < 2; ++i) { int R, C; stage_rc(tid * 16 + i * 8192, R, C); const int Rb = Epi::PERM ? ((R & ~31) + perm32(R & 31)) : R;
        voffA[i] = (unsigned)(R * K + C) * 2u; voffB[i] = (unsigned)(Rb * K + C) * 2u; }
    const size_t kstep = (size_t)(BK * 2);
    const size_t hstep = (size_t)HALF * K * 2;
    const size_t tstep = 2 * hstep;
    const unsigned ldsw = (unsigned)wid * 1024u;
    const int aoff = lds_byte(wr * 64 + fr, fq * 8), boff = lds_byte(wc * 32 + fr, fq * 8);
#define PG8_SA(b, h) (((b) * 2 + (h)) * HTB)
#define PG8_SB(b, h) ((4 + (b) * 2 + (h)) * HTB)
#define PG8_STAGE(bufoff, gbase, voff) do { _Pragma("unroll") for (int _i = 0; _i < 2; ++_i) \
        __builtin_amdgcn_global_load_lds((const unsigned*)((const char*)(gbase) + (voff)[_i]), (PG8_LAS unsigned*)(lds + (bufoff) + ldsw + _i * 8192), 16, 0, 0); } while (0)
#define PG8_LDA(dst, b, h) do { _Pragma("unroll") for (int m = 0; m < 4; ++m) _Pragma("unroll") for (int k = 0; k < 2; ++k) dst[m][k] = *(const PG8_LAS bf16x8*)(lds + PG8_SA(b, h) + aoff + m * 2048 + k * 1024); } while (0)
#define PG8_LDB(dst, b, h) do { _Pragma("unroll") for (int n = 0; n < 2; ++n) _Pragma("unroll") for (int k = 0; k < 2; ++k) dst[n][k] = *(const PG8_LAS bf16x8*)(lds + PG8_SB(b, h) + boff + n * 2048 + k * 1024); } while (0)
#define PG8_MMA(ai, bj, At, Bt) do { __builtin_amdgcn_s_setprio(1); _Pragma("unroll") for (int m = 0; m < 4; ++m) _Pragma("unroll") for (int n = 0; n < 2; ++n) _Pragma("unroll") for (int k = 0; k < 2; ++k) \
        acc[ai][bj][m][n] = __builtin_amdgcn_mfma_f32_16x16x32_bf16(Bt[n][k], At[m][k], acc[ai][bj][m][n], 0, 0, 0); __builtin_amdgcn_s_setprio(0); } while (0)
#define PG8_WAIT_V(n) asm volatile("s_waitcnt vmcnt(" #n ")" ::: "memory")
#define PG8_WAIT_L(n) asm volatile("s_waitcnt lgkmcnt(" #n ")" ::: "memory")
#define PG8_BAR __builtin_amdgcn_s_barrier()
#define PG8_SCHED __builtin_amdgcn_sched_barrier(0)
    Unit cur, nxt; int ui = 0;
    if (!S.next(0, cur)) return;
    f32x4 acc[2][2][4][2];
#pragma unroll
    for (int a = 0; a < 2; ++a)
#pragma unroll
        for (int b = 0; b < 2; ++b)
#pragma unroll
            for (int m = 0; m < 4; ++m)
#pragma unroll
                for (int n = 0; n < 2; ++n) acc[a][b][m][n] = (f32x4){0.f, 0.f, 0.f, 0.f};
    bf16x8 At[4][2], B0[2][2], B1[2][2];
    const char* cA = (const char*)g.A + cur.offA; const char* cB = (const char*)g.Bt + cur.offB;
    S.a_ready(cur);
    if constexpr (SP2) {
        PG8_STAGE(PG8_SB(0, 0), cB, voffB); PG8_STAGE(PG8_SB(0, 1), cB + hstep, voffB); PG8_STAGE(PG8_SA(0, 0), cA, voffA); PG8_STAGE(PG8_SA(0, 1), cA + hstep, voffA);
        if (wr == 1) PG8_BAR;
        PG8_WAIT_V(2); PG8_BAR;
        PG8_STAGE(PG8_SB(1, 0), cB + kstep, voffB); PG8_STAGE(PG8_SA(1, 0), cA + kstep, voffA); PG8_STAGE(PG8_SB(1, 1), cB + hstep + kstep, voffB);
        PG8_WAIT_V(6); PG8_BAR;
    } else {
        PG8_STAGE(PG8_SB(0, 0), cB, voffB); PG8_STAGE(PG8_SA(0, 0), cA, voffA); PG8_STAGE(PG8_SB(0, 1), cB + hstep, voffB); PG8_STAGE(PG8_SA(0, 1), cA + hstep, voffA);
        if (wr == 1) PG8_BAR;
        PG8_WAIT_V(4); PG8_BAR;
        PG8_STAGE(PG8_SB(1, 0), cB + kstep, voffB); PG8_STAGE(PG8_SA(1, 0), cA + kstep, voffA); PG8_STAGE(PG8_SB(1, 1), cB + hstep + kstep, voffB);
        PG8_WAIT_V(6); PG8_BAR;
    }
    for (;;) {
        const bool has_next = S.next(ui + 1, nxt);
        const char* nA = has_next ? (const char*)g.A + nxt.offA : cA; const char* nB = has_next ? (const char*)g.Bt + nxt.offB : cB;
        for (int t = 0; t < nt; t += 2) {
            const bool last = (t == nt - 2);
            const char* a1 = cA + (size_t)(t + 1) * kstep;
            const char* a2 = last ? nA : cA + (size_t)(t + 2) * kstep; const char* b2 = last ? nB : cB + (size_t)(t + 2) * kstep;
            const char* a3 = a2 + kstep; const char* b3 = b2 + kstep;
            if (last && has_next) S.a_ready(nxt);
            if constexpr (SP2) {
            PG8_LDB(B0, 0, 0); PG8_LDB(B1, 0, 1); PG8_SCHED; PG8_LDA(At, 0, 0); PG8_STAGE(PG8_SA(1, 1), a1 + hstep, voffA);
            PG8_WAIT_V(8); PG8_WAIT_L(0); PG8_BAR; PG8_MMA(0, 0, At, B0); PG8_MMA(0, 1, At, B1); PG8_BAR; PG8_SCHED;
            PG8_LDA(At, 0, 1); PG8_STAGE(PG8_SB(0, 0), b2, voffB); PG8_STAGE(PG8_SB(0, 1), b2 + hstep, voffB); PG8_STAGE(PG8_SA(0, 0), a2, voffA);
            PG8_WAIT_V(8); PG8_WAIT_L(0); PG8_BAR; PG8_MMA(1, 0, At, B0); PG8_MMA(1, 1, At, B1); PG8_BAR; PG8_SCHED;
            PG8_LDB(B0, 1, 0); PG8_LDB(B1, 1, 1); PG8_SCHED; PG8_LDA(At, 1, 0); PG8_STAGE(PG8_SA(0, 1), a2 + hstep, voffA);
            PG8_WAIT_V(8); PG8_WAIT_L(0); PG8_BAR; PG8_MMA(0, 0, At, B0); PG8_MMA(0, 1, At, B1); PG8_BAR; PG8_SCHED;
            PG8_LDA(At, 1, 1); PG8_STAGE(PG8_SB(1, 0), b3, voffB); PG8_STAGE(PG8_SB(1, 1), b3 + hstep, voffB); PG8_STAGE(PG8_SA(1, 0), a3, voffA);
            PG8_WAIT_V(8); PG8_WAIT_L(0); PG8_BAR; PG8_MMA(1, 0, At, B0); PG8_MMA(1, 1, At, B1); PG8_BAR; PG8_SCHED;
            } else {
            PG8_LDB(B0, 0, 0); PG8_SCHED; PG8_LDA(At, 0, 0); PG8_STAGE(PG8_SA(1, 1), a1 + hstep, voffA);
            PG8_WAIT_L(8); PG8_BAR; PG8_WAIT_L(0); PG8_MMA(0, 0, At, B0); PG8_BAR; PG8_SCHED;
            PG8_LDB(B1, 0, 1); PG8_STAGE(PG8_SB(0, 0), b2, voffB);
            PG8_BAR; PG8_WAIT_L(0); PG8_MMA(0, 1, At, B1); PG8_BAR;
            PG8_LDA(At, 0, 1); PG8_STAGE(PG8_SA(0, 0), a2, voffA);
            PG8_BAR; PG8_WAIT_L(0); PG8_MMA(1, 0, At, B0); PG8_BAR; PG8_SCHED;
            PG8_STAGE(PG8_SB(0, 1), b2 + hstep, voffB);
            PG8_WAIT_V(6); PG8_BAR; PG8_MMA(1, 1, At, B1); PG8_BAR;
            PG8_LDB(B0, 1, 0); PG8_SCHED; PG8_LDA(At, 1, 0); PG8_STAGE(PG8_SA(0, 1), a2 + hstep, voffA);
            PG8_WAIT_L(8); PG8_BAR; PG8_WAIT_L(0); PG8_MMA(0, 0, At, B0); PG8_BAR; PG8_SCHED;
            PG8_LDB(B1, 1, 1); PG8_STAGE(PG8_SB(1, 0), b3, voffB);
            PG8_BAR; PG8_WAIT_L(0); PG8_MMA(0, 1, At, B1); PG8_BAR;
            PG8_LDA(At, 1, 1); PG8_STAGE(PG8_SA(1, 0), a3, voffA);
            PG8_BAR; PG8_WAIT_L(0); PG8_MMA(1, 0, At, B0); PG8_BAR; PG8_SCHED;
            PG8_STAGE(PG8_SB(1, 1), b3 + hstep, voffB);
            PG8_WAIT_V(6); PG8_BAR; PG8_MMA(1, 1, At, B1); PG8_BAR;
            }
        }
        if constexpr (ALIGN_EPI) { if (wr == 0) PG8_BAR; }
        if constexpr (!Epi::AFTER_DRAIN) { E(acc, cur, wr, wc, fr, fq); S.done(cur); }
        if (!has_next) break;
#pragma unroll
        for (int a = 0; a < 2; ++a)
#pragma unroll
            for (int b = 0; b < 2; ++b)
#pragma unroll
                for (int m = 0; m < 4; ++m)
#pragma unroll
                    for (int n = 0; n < 2; ++n) acc[a][b][m][n] = (f32x4){0.f, 0.f, 0.f, 0.f};
        cur = nxt; cA = nA; cB = nB; ++ui;
        if constexpr (ALIGN_EPI) { if (wr == 1) PG8_BAR; }
    }
    PG8_WAIT_V(0);
    if constexpr (!ALIGN_EPI) { if (wr == 0) PG8_BAR; }
    PG8_BAR;
    if constexpr (Epi::AFTER_DRAIN) { E.fused(acc, cur, wr, wc, fr, fq, lds, wid, lane); S.done(cur); }
#undef PG8_SA
#undef PG8_SB
#undef PG8_STAGE
#undef PG8_LDA
#undef PG8_LDB
#undef PG8_MMA
#undef PG8_WAIT_V
#undef PG8_WAIT_L
#undef PG8_BAR
#undef PG8_SCHED
}
}

using pg8::bf16_t; using pg8::f32x4; using pg8::u32x4; using pg8::bf16x8; using pg8::Unit;
#define GAS __attribute__((address_space(1)))
#define LAS __attribute__((address_space(3)))
typedef unsigned u32x2 __attribute__((ext_vector_type(2)));

constexpr int D = 1024, TP = 4096, TS = 8192, T = TP + TS, FF = 2816, NL = 4;
constexpr int NWAVES = 8, NTHR = 512;
constexpr float EPS = 1e-6f;
constexpr float LOG2E = 1.4426950408889634f;
constexpr float QSCALE = 0.125f * LOG2E;

constexpr size_t MiB = 1u << 20;
constexpr size_t WS_W1T = 0;
constexpr size_t WS_W2T = 88 * MiB;
constexpr size_t WS_FINT = 132 * MiB;
constexpr size_t WS_FOUTT = 140 * MiB;
constexpr size_t WS_WQKVT = 148 * MiB;
constexpr size_t WS_WOT = 160 * MiB;
constexpr size_t WS_WINB = 164 * MiB;
constexpr size_t WS_CST = 168 * MiB;
constexpr size_t WS_DFTS = 172 * MiB;
constexpr size_t WS_DFTP = 236 * MiB;
constexpr size_t WS_MOD = 237 * MiB;
constexpr size_t WS_SMALL = 237 * MiB + 448 * 1024;
constexpr size_t WS_CK = 238 * MiB;
constexpr size_t WS_CVT = 240 * MiB;
constexpr size_t WS_H = 242 * MiB;
constexpr size_t WS_A = 266 * MiB;
constexpr size_t WS_Y = 332 * MiB;
constexpr size_t WS_MIX = 356 * MiB;
constexpr size_t WS_CTL = 452 * MiB;
constexpr size_t CTL_BYTES = 16384;
constexpr size_t WS_END = 453 * MiB;
constexpr int LDS_BYTES = 131072 + 1024;

__device__ __forceinline__ float bf2f(unsigned b) { return __builtin_bit_cast(float, b << 16); }
typedef float f32x2_t __attribute__((ext_vector_type(2)));
typedef __bf16 bf16x2_t __attribute__((ext_vector_type(2)));
__device__ __forceinline__ unsigned pk2(float lo, float hi) { const f32x2_t v = {lo, hi}; const bf16x2_t b = __builtin_convertvector(v, bf16x2_t); return __builtin_bit_cast(unsigned, b); }
__device__ __forceinline__ float wave_sum(float v) {
#pragma unroll
    for (int o = 1; o < 64; o <<= 1) v += __shfl_xor(v, o);
    return v;
}

struct Order {
    int nM, nN, nwg, total, G, c; unsigned tA, zAl, zBh, zBl;
    __device__ __forceinline__ void init(int M, int N, int K, int nZ, int G_, int c_, unsigned zAl_, unsigned zBh_, unsigned zBl_) {
        nM = M / 256; nN = N / 256; nwg = nM * nN; total = nwg * nZ; G = G_; c = c_; tA = 512u * (unsigned)K; zAl = zAl_; zBh = zBh_; zBl = zBl_; }
    __device__ __forceinline__ bool next(int i, Unit& u) const {
        const int L = i * G + c; if (L >= total) return false;
        const int z = L / nwg; int wgid = L % nwg;
        { const int q = nwg / 8, r = nwg % 8, xcd = wgid % 8, off = wgid / 8; wgid = (xcd < r ? xcd * (q + 1) : r * (q + 1) + (xcd - r) * q) + off; }
        const int nig = 8 * nN, gid = wgid / nig, fm = gid * 8, gsz = (nM - fm) < 8 ? (nM - fm) : 8;
        u.pm = fm + ((wgid % nig) % gsz); u.pn = (wgid % nig) / gsz; u.z = z;
        u.offA = (unsigned)u.pm * tA + (unsigned)(z & 1) * zAl;
        u.offB = (unsigned)u.pn * tA + (unsigned)(z >> 1) * zBh + (unsigned)(z & 1) * zBl;
        return true;
    }
    __device__ __forceinline__ void a_ready(const Unit&) const {}
    __device__ __forceinline__ void done(const Unit&) const {}
};

typedef f32x4 AccT[2][2][4][2];
__device__ __forceinline__ void store_tile_bf16(const AccT& acc, bf16_t* base, size_t ldc, int wr, int wc, int fr, int fq, float sc) {
    bf16_t* p0 = base + (size_t)(wr * 64 + fr) * ldc + wc * 32 + 8 * fq;
#pragma unroll
    for (int ai = 0; ai < 2; ++ai)
#pragma unroll
        for (int m = 0; m < 4; ++m) { bf16_t* rowp = p0 + (size_t)(ai * 128 + m * 16) * ldc;
#pragma unroll
            for (int bj = 0; bj < 2; ++bj) { const f32x4 v0 = acc[ai][bj][m][0] * sc, v1 = acc[ai][bj][m][1] * sc;
                u32x4 w; w.x = pk2(v0[0], v0[1]); w.y = pk2(v0[2], v0[3]); w.z = pk2(v1[0], v1[1]); w.w = pk2(v1[2], v1[3]);
                *(u32x4*)(rowp + bj * 128) = w; } }
}
__device__ __forceinline__ float silu_mul(float g, float u) { return g * __builtin_amdgcn_rcpf(1.f + __builtin_amdgcn_exp2f(-g * LOG2E)) * u; }

enum { EK_SWIGLU = 0, EK_Y = 1, EK_FOLD = 2, EK_UT = 3, EK_POSP = 4, EK_POSS = 5, EK_QKV = 6 };
struct EpiMulti {
    static constexpr bool PERM = true, AFTER_DRAIN = false; int kind, jl; unsigned char* ws; float* out;
    __device__ __forceinline__ void operator()(const AccT& acc, const Unit& u, int wr, int wc, int fr, int fq) const {
        if (kind == EK_SWIGLU) {
            bf16_t* p0 = (bf16_t*)(ws + WS_A) + (size_t)(u.pm * 256 + wr * 64 + fr) * FF + u.pn * 128 + wc * 32 + 8 * fq;
#pragma unroll
            for (int ai = 0; ai < 2; ++ai)
#pragma unroll
                for (int m = 0; m < 4; ++m) { const f32x4 g0 = acc[ai][0][m][0], g1 = acc[ai][0][m][1], u0 = acc[ai][1][m][0], u1 = acc[ai][1][m][1];
                    u32x4 w; w.x = pk2(silu_mul(g0[0], u0[0]), silu_mul(g0[1], u0[1])); w.y = pk2(silu_mul(g0[2], u0[2]), silu_mul(g0[3], u0[3]));
                    w.z = pk2(silu_mul(g1[0], u1[0]), silu_mul(g1[1], u1[1])); w.w = pk2(silu_mul(g1[2], u1[2]), silu_mul(g1[3], u1[3]));
                    *(u32x4*)(p0 + (size_t)(ai * 128 + m * 16) * FF) = w; }
            return;
        }
        if (kind != EK_QKV) {
            bf16_t* base; size_t ldc = 1024;
            if (kind == EK_Y) base = (bf16_t*)(ws + WS_Y) + (size_t)u.pm * 256 * 1024 + u.pn * 256;
            else if (kind == EK_FOLD) base = (bf16_t*)(ws + WS_FINT) + (size_t)u.z * 2048 * 1024 + (size_t)u.pm * 256 * 1024 + u.pn * 256;
            else if (kind == EK_UT) {
                bf16_t* UT = (bf16_t*)(ws + WS_MIX);
                if (u.pn < 16) { ldc = 256; base = UT + (size_t)u.pn * (2048 * 256) + (size_t)u.pm * 256 * 256; }
                else { const int sb = (u.pn - 16) >> 4, s0 = ((u.pn - 16) & 15) * 256; ldc = 4096; base = UT + (size_t)16 * 2048 * 256 + (size_t)sb * (2048 * 4096) + (size_t)u.pm * 256 * 4096 + s0; }
            } else {
                const int tok0 = kind == EK_POSS ? TP : 0, S = kind == EK_POSS ? 4096 : 256; ldc = 2048;
                base = (bf16_t*)(ws + WS_MIX + 48 * MiB) + (size_t)(tok0 + (u.z >> 1) * S + u.pm * 256) * 2048 + (u.z & 1) * 1024 + u.pn * 256;
            }
            store_tile_bf16(acc, base, ldc, wr, wc, fr, fq, 1.f);
            return;
        }
        const int sect = u.pn >> 2, coff = (u.pn & 3) * 256;
        if (sect == 0) { store_tile_bf16(acc, (bf16_t*)(ws + WS_MIX) + (size_t)u.pm * 256 * D + coff, D, wr, wc, fr, fq, QSCALE); return; }
        if (sect == 1) store_tile_bf16(acc, (bf16_t*)(ws + WS_MIX + 24 * MiB) + (size_t)u.pm * 256 * D + coff, D, wr, wc, fr, fq, 1.f);
        else {
            bf16_t* VT = (bf16_t*)(ws + WS_MIX + 48 * MiB);
#pragma unroll
            for (int ai = 0; ai < 2; ++ai)
#pragma unroll
                for (int m = 0; m < 4; ++m) { const int r = u.pm * 256 + ai * 128 + wr * 64 + m * 16 + fr;
#pragma unroll
                    for (int bj = 0; bj < 2; ++bj)
#pragma unroll
                        for (int n = 0; n < 2; ++n)
#pragma unroll
                            for (int e = 0; e < 4; e += 2) { const int c = coff + bj * 128 + wc * 32 + 8 * fq + 4 * n + e; const unsigned w = pk2(acc[ai][bj][m][n][e], acc[ai][bj][m][n][e + 1]);
                                VT[(size_t)c * T + r] = (bf16_t)(w & 0xffffu); VT[(size_t)(c + 1) * T + r] = (bf16_t)(w >> 16); } }
        }
        if (u.pm < 16) {
            float* dst = out + (size_t)T * D + (sect == 1 ? (size_t)0 : (size_t)16 * 2 * 16 * 256 * 64) + (size_t)(u.pm * 2 + jl) * 16 * 256 * 64;
#pragma unroll
            for (int ai = 0; ai < 2; ++ai)
#pragma unroll
                for (int m = 0; m < 4; ++m) { const int s = ai * 128 + wr * 64 + m * 16 + fr;
#pragma unroll
                    for (int bj = 0; bj < 2; ++bj) { const int c = coff + bj * 128 + wc * 32 + 8 * fq; float* p = dst + ((size_t)(c >> 6) * 256 + s) * 64 + (c & 63);
                        *(f32x4*)p = acc[ai][bj][m][0]; *(f32x4*)(p + 4) = acc[ai][bj][m][1]; } }
        }
    }
};

__device__ __forceinline__ void ew_phase(const bool FIRST, const bool LAST, const float* xin_p, const float* xin_s, float* x, const bf16_t* y, const float* modg, int gi, float coef, const float* gpost,
                                         const float* gpre, const float* modn, int si, bf16_t* h, int gw, int NGW, int lane) {
    for (int r = gw; r < T; r += NGW) {
        const int ci = r < TP ? 0 : 1 + ((r - TP) >> 12);
        f32x4 xv[4];
        if (FIRST) {
            const float* src = r < TP ? xin_p + (size_t)r * D : xin_s + (size_t)(r - TP) * D;
#pragma unroll
            for (int j = 0; j < 4; ++j) xv[j] = *(const f32x4*)(src + 256 * j + 4 * lane);
        } else {
            const float* xr = x + (size_t)r * D; const bf16_t* yr = y + (size_t)r * D;
            f32x4 yv[4]; float ss = 0.f;
#pragma unroll
            for (int j = 0; j < 4; ++j) { xv[j] = *(const f32x4*)(xr + 256 * j + 4 * lane); const u32x2 yb = *(const u32x2*)(yr + 256 * j + 4 * lane);
                yv[j] = (f32x4){bf2f(yb.x & 0xffffu), bf2f(yb.x >> 16), bf2f(yb.y & 0xffffu), bf2f(yb.y >> 16)};
                ss += (yv[j][0] * yv[j][0] + yv[j][1] * yv[j][1]) + (yv[j][2] * yv[j][2] + yv[j][3] * yv[j][3]); }
            const float ry = coef * __builtin_amdgcn_rsqf(wave_sum(ss) * (1.f / D) + EPS);
            const float* mg = modg + ci * 9216 + gi * 1024;
#pragma unroll
            for (int j = 0; j < 4; ++j) { const f32x4 g = *(const f32x4*)(mg + 256 * j + 4 * lane), gp = *(const f32x4*)(gpost + 256 * j + 4 * lane); xv[j] += ry * g * gp * yv[j]; }
        }
        float* xo = x + (size_t)r * D;
#pragma unroll
        for (int j = 0; j < 4; ++j) *(f32x4*)(xo + 256 * j + 4 * lane) = xv[j];
        if (!LAST) {
            float ss = 0.f;
#pragma unroll
            for (int j = 0; j < 4; ++j) ss += (xv[j][0] * xv[j][0] + xv[j][1] * xv[j][1]) + (xv[j][2] * xv[j][2] + xv[j][3] * xv[j][3]);
            const float rx = __builtin_amdgcn_rsqf(wave_sum(ss) * (1.f / D) + EPS);
            const float* msh = modn + ci * 9216 + si * 1024; const float* msc = msh + 1024; bf16_t* hr = h + (size_t)r * D;
#pragma unroll
            for (int j = 0; j < 4; ++j) { const f32x4 gp = *(const f32x4*)(gpre + 256 * j + 4 * lane), sh = *(const f32x4*)(msh + 256 * j + 4 * lane), sc = *(const f32x4*)(msc + 256 * j + 4 * lane);
                const f32x4 hv = xv[j] * rx * gp * (1.f + sc) + sh; u32x2 w; w.x = pk2(hv[0], hv[1]); w.y = pk2(hv[2], hv[3]); *(u32x2*)(hr + 256 * j + 4 * lane) = w; }
        }
    }
}

__device__ __forceinline__ void transpose_item(const float* W, int N, bf16_t* WT, size_t ldw, int dst_row0, int dst_col0, LAS float* scr, int k0, int n0, int lane) {
#pragma unroll 8
    for (int i = 0; i < 32; ++i) { const int kk = 2 * i + (lane >> 5); scr[kk * 33 + (lane & 31)] = W[(size_t)(k0 + kk) * N + n0 + (lane & 31)]; }
    asm volatile("s_waitcnt lgkmcnt(0)" ::: "memory");
    const int c = lane & 7;
#pragma unroll
    for (int j = 0; j < 4; ++j) { const int n = (lane >> 3) + 8 * j; const LAS float* s = scr + (8 * c) * 33 + n;
        u32x4 o; o.x = pk2(s[0 * 33], s[1 * 33]); o.y = pk2(s[2 * 33], s[3 * 33]); o.z = pk2(s[4 * 33], s[5 * 33]); o.w = pk2(s[6 * 33], s[7 * 33]);
        *(u32x4*)(WT + (size_t)(dst_row0 + n) * ldw + dst_col0 + k0 + 8 * c) = o; }
    asm volatile("s_waitcnt lgkmcnt(0)" ::: "memory");
}

struct Args { const float* in[17]; float* out; unsigned char* ws; };

__device__ __forceinline__ void prologue(const Args& a, LAS unsigned char* lds, int G, int tid, unsigned char* ws) {
    const int lane = tid & 63, wave = __builtin_amdgcn_readfirstlane(tid >> 6);
    {
        LAS float* ssc = (LAS float*)lds; LAS float* red = (LAS float*)(lds + 16384);
        const float* c = a.in[4]; const float* cctx = a.in[5];
        for (int i = tid; i < 3 * 1024; i += NTHR) { const int ci = i >> 10, k = i & 1023; const float v = ci == 0 ? cctx[k] : c[(ci - 1) * 1024 + k];
            ssc[i] = v * __builtin_amdgcn_rcpf(1.f + __builtin_amdgcn_exp2f(-v * LOG2E)); }
        __syncthreads();
        const int cg4 = tid & 31, ks = tid >> 5;
        for (int item = blockIdx.x; item < 4 * 72; item += G) {
            const int l = item / 72, jc = item % 72;
            const float* wp = a.in[6] + (size_t)l * 1024 * 9216 + (size_t)(ks * 64) * 9216 + jc * 128 + cg4 * 4;
            f32x4 a0 = {0.f, 0.f, 0.f, 0.f}, a1 = a0, a2 = a0;
#pragma unroll 8
            for (int kk = 0; kk < 64; ++kk) { const f32x4 w = *(const f32x4*)(wp + (size_t)kk * 9216); const int k = ks * 64 + kk;
                a0 += ssc[k] * w; a1 += ssc[1024 + k] * w; a2 += ssc[2048 + k] * w; }
            __syncthreads();
#pragma unroll
            for (int e = 0; e < 4; ++e) { red[(ks * 3 + 0) * 128 + cg4 * 4 + e] = a0[e]; red[(ks * 3 + 1) * 128 + cg4 * 4 + e] = a1[e]; red[(ks * 3 + 2) * 128 + cg4 * 4 + e] = a2[e]; }
            __syncthreads();
            if (tid < 384) { const int ci = tid >> 7, col = tid & 127; float s = a.in[7][l * 9216 + jc * 128 + col];
#pragma unroll
                for (int q = 0; q < 16; ++q) s += red[(q * 3 + ci) * 128 + col];
                ((float*)(ws + WS_MOD))[(l * 3 + ci) * 9216 + jc * 128 + col] = s; }
        }
        __syncthreads();
    }
    {
        LAS float* scr = (LAS float*)(lds + wave * 16384);
        const int gw = blockIdx.x * NWAVES + wave, NGW = G * NWAVES;
        constexpr int I_W1 = 8 * 2816, I_W2 = 8 * 1408, I_FO = 2 * 1024, I_QKV = 2 * 1536, I_WO = 2 * 512, I_CV = 64 * 8;
        constexpr int NITEMS = I_W1 + I_W2 + I_FO + I_QKV + I_WO + I_CV;
        for (int it = gw; it < NITEMS; it += NGW) {
            int r = it;
            if (r < I_W1) { const int mat = r / 2816, rem = r % 2816, kb = rem / 176, nb = rem % 176, n0 = nb * 32;
                const int row0 = n0 < FF ? 256 * (n0 / 128) + (n0 % 128) : 256 * ((n0 - FF) / 128) + 128 + ((n0 - FF) % 128);
                transpose_item(a.in[10] + (size_t)mat * 1024 * 5632, 5632, (bf16_t*)(ws + WS_W1T) + (size_t)mat * 5632 * 1024, 1024, row0, 0, scr, kb * 64, n0, lane); continue; } r -= I_W1;
            if (r < I_W2) { const int mat = r / 1408, rem = r % 1408, kb = rem / 32, nb = rem % 32;
                transpose_item(a.in[11] + (size_t)mat * FF * 1024, 1024, (bf16_t*)(ws + WS_W2T) + (size_t)mat * 1024 * FF, FF, nb * 32, 0, scr, kb * 64, nb * 32, lane); continue; } r -= I_W2;
            if (r < I_FO) { const int mat = r / 1024, rem = r % 1024, dup = rem / 512, rem2 = rem % 512, kb = rem2 / 32, nb = rem2 % 32;
                transpose_item(a.in[13] + (size_t)mat * 1024 * 1024, 1024, (bf16_t*)(ws + WS_FOUTT) + (size_t)mat * 1024 * 2048, 2048, nb * 32, dup * 1024, scr, kb * 64, nb * 32, lane); continue; } r -= I_FO;
            if (r < I_QKV) { const int mat = r / 1536, rem = r % 1536, kb = rem / 96, nb = rem % 96;
                transpose_item(a.in[14] + (size_t)mat * 1024 * 3072, 3072, (bf16_t*)(ws + WS_WQKVT) + (size_t)mat * 3072 * 1024, 1024, nb * 32, 0, scr, kb * 64, nb * 32, lane); continue; } r -= I_QKV;
            if (r < I_WO) { const int mat = r / 512, rem = r % 512, kb = rem / 32, nb = rem % 32;
                transpose_item(a.in[15] + (size_t)mat * 1024 * 1024, 1024, (bf16_t*)(ws + WS_WOT) + (size_t)mat * 1024 * 1024, 1024, nb * 32, 0, scr, kb * 64, nb * 32, lane); continue; } r -= I_WO;
            { const int mat = r / 8, rem = r % 8, kb = rem / 2, nb = rem % 2;
                transpose_item(a.in[3] + (size_t)mat * 256 * 64, 64, (bf16_t*)(ws + WS_CVT) + (size_t)mat * 64 * 256, 256, nb * 32, 0, scr, kb * 64, nb * 32, lane); }
        }
    }
    {
        const long gt = (long)blockIdx.x * NTHR + tid, NT = (long)G * NTHR;
        for (long i = gt; i < 12288 + 12288 + 14880; i += NT) {
            float* dst = (float*)(ws + WS_SMALL); dst[i] = i < 12288 ? a.in[8][i] : (i < 24576 ? a.in[9][i - 12288] : a.in[16][i - 24576]); }
        constexpr long E_WIN = 2L * 1024 * 1024 / 8, E_CK = 1024L * 1024 / 8, E_CST = 2048L * 1024 / 8, E_DS = 2L * 4096 * 4096 / 8, E_DP = 2L * 256 * 256 / 8;
        constexpr long NE = E_WIN + E_CK + E_CST + E_DS + E_DP;
        for (long it = gt; it < NE; it += NT) {
            long r = it; u32x4 o;
            if (r < E_WIN + E_CK) { const float* src; bf16_t* dst;
                if (r < E_WIN) { src = a.in[12] + r * 8; dst = (bf16_t*)(ws + WS_WINB) + r * 8; } else { r -= E_WIN; src = a.in[2] + r * 8; dst = (bf16_t*)(ws + WS_CK) + r * 8; }
                const f32x4 v0 = *(const f32x4*)src, v1 = *(const f32x4*)(src + 4);
                o.x = pk2(v0[0], v0[1]); o.y = pk2(v0[2], v0[3]); o.z = pk2(v1[0], v1[1]); o.w = pk2(v1[2], v1[3]); *(u32x4*)dst = o; continue; }
            r -= E_WIN + E_CK;
            if (r < E_CST) { const int mp = (int)(r >> 7), c0 = (int)(r & 127) * 8, cs = mp >> 10, n = mp & 1023, g = n >> 7, q = n & 127;
                float v[8];
#pragma unroll
                for (int e = 0; e < 8; ++e) { const int cc = (c0 & 127) + e; const float fr = (float)((cc * q) & 127) * (1.f / 128.f);
                    const float t = cs ? __builtin_amdgcn_sinf(fr) : __builtin_amdgcn_cosf(fr); v[e] = ((c0 >> 7) == g) ? t * 0.08838834764831845f : 0.f; }
                o.x = pk2(v[0], v[1]); o.y = pk2(v[2], v[3]); o.z = pk2(v[4], v[5]); o.w = pk2(v[6], v[7]); *(u32x4*)((bf16_t*)(ws + WS_CST) + r * 8) = o; continue; }
            r -= E_CST;
            if (r < E_DS) { const int mat = (int)(r >> 21), rem = (int)(r & ((1 << 21) - 1)), p = rem >> 9, s0 = (rem & 511) * 8;
                float v[8];
#pragma unroll
                for (int e = 0; e < 8; ++e) { const float fr = (float)((p * (s0 + e)) & 4095) * (1.f / 4096.f);
                    v[e] = mat ? -__builtin_amdgcn_sinf(fr) * (1.f / 64.f) : __builtin_amdgcn_cosf(fr) * (1.f / 64.f); }
                o.x = pk2(v[0], v[1]); o.y = pk2(v[2], v[3]); o.z = pk2(v[4], v[5]); o.w = pk2(v[6], v[7]); *(u32x4*)((bf16_t*)(ws + WS_DFTS) + r * 8) = o; continue; }
            r -= E_DS;
            { const int mat = (int)(r >> 13), rem = (int)(r & 8191), p = rem >> 5, s0 = (rem & 31) * 8;
                float v[8];
#pragma unroll
                for (int e = 0; e < 8; ++e) { const float fr = (float)((p * (s0 + e)) & 255) * (1.f / 256.f);
                    v[e] = mat ? -__builtin_amdgcn_sinf(fr) * (1.f / 16.f) : __builtin_amdgcn_cosf(fr) * (1.f / 16.f); }
                o.x = pk2(v[0], v[1]); o.y = pk2(v[2], v[3]); o.z = pk2(v[4], v[5]); o.w = pk2(v[6], v[7]); *(u32x4*)((bf16_t*)(ws + WS_DFTP) + r * 8) = o; }
        }
    }
}

constexpr int VS_CTX = 256 + 16, VS_LOC = 576 + 16;
constexpr int ALDS_VCTX = 0, ALDS_VLOC = 64 * VS_CTX * 2, ALDS_RPB = ALDS_VLOC + 64 * VS_LOC * 2;
static_assert(ALDS_RPB + 465 * 4 <= 131072, "attention LDS map");
struct KSrc { const char* base; unsigned voff, s16, sRJ, chunk; };
__device__ __forceinline__ void attn_loadk(bf16x8 (&kf)[8], const char* ubase, unsigned voff, unsigned s16, unsigned sRJ) {
#pragma unroll
    for (int t = 0; t < 4; ++t) { const char* tb = ubase + (size_t)((t & 1) * s16 + (t >> 1) * sRJ);
#pragma unroll
        for (int kk = 0; kk < 2; ++kk) kf[t * 2 + kk] = *(const bf16x8*)(tb + voff + kk * 64); }
}
__device__ __forceinline__ void attn_chunk(const bool LOCAL, f32x4 (&o)[4], float& m, float& l, const bf16x8 (&qf)[2], const bf16x8 (&kf)[8], const LAS bf16_t* vl, int vstride,
                                           const LAS float* rp, int i0, int rs, int r, int cs0, int c, int fr, int fq) {
    const int RJ = LOCAL ? 64 : 32;
    f32x4 s[4];
#pragma unroll
    for (int t = 0; t < 4; ++t) { s[t] = (f32x4){0.f, 0.f, 0.f, 0.f};
#pragma unroll
        for (int kk = 0; kk < 2; ++kk) s[t] = __builtin_amdgcn_mfma_f32_16x16x32_bf16(kf[t * 2 + kk], qf[kk], s[t], 0, 0, 0); }
    if (LOCAL) {
        const int cstart = c < 8 ? 0 : (c > 56 ? 48 : c - 8);
#pragma unroll
        for (int t = 0; t < 4; ++t) { const int i = i0 + (t >> 1); const int bo = (rs + i - r + 7) * 31 + 15 - c;
#pragma unroll
            for (int j = 0; j < 4; ++j) { const int kc = cs0 + 16 * (t & 1) + 4 * fq + j; const bool ok = kc >= cstart && kc < cstart + 16;
                const float bias = rp[ok ? bo + kc : 0]; s[t][j] = ok ? s[t][j] + bias : -1e30f; } }
    }
    float mx = s[0][0];
#pragma unroll
    for (int t = 0; t < 4; ++t)
#pragma unroll
        for (int j = 0; j < 4; ++j) mx = fmaxf(mx, s[t][j]);
    mx = fmaxf(mx, __shfl_xor(mx, 16)); mx = fmaxf(mx, __shfl_xor(mx, 32));
    const float mn = fmaxf(m, mx), alpha = __builtin_amdgcn_exp2f(m - mn); m = mn;
    float ls = 0.f;
#pragma unroll
    for (int t = 0; t < 4; ++t)
#pragma unroll
        for (int j = 0; j < 4; ++j) { s[t][j] = __builtin_amdgcn_exp2f(s[t][j] - mn); ls += s[t][j]; }
    l = l * alpha + ls;
#pragma unroll
    for (int j = 0; j < 4; ++j) { const float af = __shfl(alpha, 4 * fq + j);
#pragma unroll
        for (int dt = 0; dt < 4; ++dt) o[dt][j] *= af; }
#pragma unroll
    for (int kb2 = 0; kb2 < 2; ++kb2) {
        u32x4 pw; pw.x = pk2(s[2 * kb2][0], s[2 * kb2][1]); pw.y = pk2(s[2 * kb2][2], s[2 * kb2][3]); pw.z = pk2(s[2 * kb2 + 1][0], s[2 * kb2 + 1][1]); pw.w = pk2(s[2 * kb2 + 1][2], s[2 * kb2 + 1][3]);
        const bf16x8 pa = __builtin_bit_cast(bf16x8, pw);
#pragma unroll
        for (int dt = 0; dt < 4; ++dt) { const LAS bf16_t* vp = vl + dt * 16 * vstride + kb2 * RJ;
            u32x4 vw; const u32x2 v0 = *(const LAS u32x2*)vp, v1 = *(const LAS u32x2*)(vp + 16); vw.x = v0.x; vw.y = v0.y; vw.z = v1.x; vw.w = v1.y;
            o[dt] = __builtin_amdgcn_mfma_f32_16x16x32_bf16(pa, __builtin_bit_cast(bf16x8, vw), o[dt], 0, 0, 0); }
    }
}
__device__ __forceinline__ void attn_wave(const bf16_t* Q, bf16_t* O, int tokq0, int hh, int nch, const KSrc ka, const KSrc kb, const LAS bf16_t* va, const LAS bf16_t* vb,
                                          const LAS float* rp, int rs, int r, int cs0, int c, int fr, int fq) {
    f32x4 o[4]; float m = -1e30f, l = 0.f; bf16x8 qf[2];
#pragma unroll
    for (int dt = 0; dt < 4; ++dt) o[dt] = (f32x4){0.f, 0.f, 0.f, 0.f};
    const bf16_t* qp = Q + (size_t)(tokq0 + fr) * D + hh * 64 + fq * 8; qf[0] = *(const bf16x8*)qp; qf[1] = *(const bf16x8*)(qp + 32);
    bf16x8 kcur[8], knext[8];
    attn_loadk(kcur, ka.base, ka.voff, ka.s16, ka.sRJ);
#pragma unroll 1
    for (int ch = 0; ch < nch; ++ch) {
        const int c1 = ch + 1 < nch ? ch + 1 : ch; const bool l1 = c1 >= 4;
        attn_loadk(knext, l1 ? kb.base + (size_t)(c1 - 4) * kb.chunk : ka.base + (size_t)c1 * ka.chunk, l1 ? kb.voff : ka.voff, l1 ? kb.s16 : ka.s16, l1 ? kb.sRJ : ka.sRJ);
        const bool loc = ch >= 4;
        attn_chunk(loc, o, m, l, qf, kcur, loc ? vb + (ch - 4) * 128 : va + ch * 64, loc ? VS_LOC : VS_CTX, rp, 2 * (ch - 4), rs, r, cs0, c, fr, fq);
#pragma unroll
        for (int i = 0; i < 8; ++i) kcur[i] = knext[i];
    }
    float lt = l + __shfl_xor(l, 16); lt += __shfl_xor(lt, 32);
    const float inv = __builtin_amdgcn_rcpf(lt);
#pragma unroll
    for (int j = 0; j < 4; ++j) { const float ij = __shfl(inv, 4 * fq + j); bf16_t* op = O + (size_t)(tokq0 + 4 * fq + j) * D + hh * 64 + fr;
#pragma unroll
        for (int dt = 0; dt < 4; ++dt) op[dt * 16] = (bf16_t)(pk2(o[dt][j] * ij, 0.f) & 0xffffu); }
}

__device__ __forceinline__ void attn_phase(LAS unsigned char* lds, const bf16_t* Q, const bf16_t* Kb, const bf16_t* VT, const bf16_t* ck, const bf16_t* cvt, const float* rpb, bf16_t* O, int jl, int cu, int G, int tid) {
    const int lane = tid & 63, wave = __builtin_amdgcn_readfirstlane(tid >> 6), fr = lane & 15, fq = lane >> 4;
    LAS bf16_t* vctx = (LAS bf16_t*)(lds + ALDS_VCTX); LAS bf16_t* vloc = (LAS bf16_t*)(lds + ALDS_VLOC); LAS float* rp = (LAS float*)(lds + ALDS_RPB);
    for (int grp = cu; grp < 256; grp += G) {
        const int b = grp >> 7, hh = (grp >> 3) & 15, rq = grp & 7;
        __syncthreads();
        { const bf16_t* src = cvt + (size_t)((b * 2 + jl) * 16 + hh) * 64 * 256;
#pragma unroll
          for (int i = 0; i < 4; ++i) { const int p = tid + i * NTHR, d = p >> 5, ch = p & 31; *(LAS u32x4*)(vctx + d * VS_CTX + ch * 8) = *(const u32x4*)(src + d * 256 + ch * 8); }
          if (tid < 465) rp[tid] = rpb[hh * 465 + tid] * LOG2E; }
        KSrc ka; ka.base = (const char*)(ck + (size_t)((b * 2 + jl) * 16 + hh) * 256 * 64); ka.voff = (unsigned)(fr * 64 + fq * 8) * 2u; ka.s16 = 16u * 64u * 2u; ka.sRJ = 32u * 64u * 2u; ka.chunk = 64u * 64u * 2u;
#pragma unroll 1
        for (int rpi = 0; rpi < 4; ++rpi) {
            const int r0 = rq * 8 + rpi * 2, rsA = r0 < 4 ? 0 : (r0 > 60 ? 56 : r0 - 4);
            if (rpi > 0) __syncthreads();
            { const int d = tid >> 3, ch = tid & 7; const bf16_t* src = VT + (size_t)(hh * 64 + d) * T + TP + b * 4096 + rsA * 64 + ch * 8;
#pragma unroll
              for (int i = 0; i < 9; ++i) if (rsA + i < 64) *(LAS u32x4*)(vloc + d * VS_LOC + i * 64 + ch * 8) = *(const u32x4*)(src + i * 64); }
            __syncthreads();
            const int r = r0 + (wave >> 2), quarter = wave & 3, c0 = quarter * 16, cs0 = c0 < 8 ? 0 : (c0 - 8 > 32 ? 32 : c0 - 8), rs = r < 4 ? 0 : (r > 60 ? 56 : r - 4);
            KSrc kb; kb.base = (const char*)(Kb + (size_t)(TP + b * 4096 + rs * 64 + cs0) * D + hh * 64); kb.voff = (unsigned)(fr * D + fq * 8) * 2u; kb.s16 = 16u * D * 2u; kb.sRJ = 64u * D * 2u; kb.chunk = 128u * D * 2u;
            attn_wave(Q, O, TP + b * 4096 + r * 64 + c0, hh, 8, ka, kb, vctx + fr * VS_CTX + fq * 4, vloc + fr * VS_LOC + (rs - rsA) * 64 + cs0 + fq * 4, rp, rs, r, cs0, c0 + fr, fr, fq);
        }
    }
    for (int pu = cu; pu < 256; pu += G) {
        const int b = pu >> 4, hh = pu & 15;
        __syncthreads();
        { const bf16_t* src = VT + (size_t)(hh * 64) * T + b * 256;
#pragma unroll
          for (int i = 0; i < 4; ++i) { const int p = tid + i * NTHR, d = p >> 5, ch = p & 31; *(LAS u32x4*)(vctx + d * VS_CTX + ch * 8) = *(const u32x4*)(src + (size_t)d * T + ch * 8); } }
        __syncthreads();
        KSrc ka; ka.base = (const char*)(Kb + (size_t)(b * 256) * D + hh * 64); ka.voff = (unsigned)(fr * D + fq * 8) * 2u; ka.s16 = 16u * D * 2u; ka.sRJ = 32u * D * 2u; ka.chunk = 64u * D * 2u;
#pragma unroll 1
        for (int qi = 0; qi < 2; ++qi)
            attn_wave(Q, O, b * 256 + (wave * 2 + qi) * 16, hh, 4, ka, ka, vctx + fr * VS_CTX + fq * 4, vctx, rp, 0, 0, 0, 0, fr, fq);
    }
    __syncthreads();
}

#define XB_TMO      128
#define XB_XCNT(j)  (256  + 64 * (j))
#define XB_XSUB(j)  (1280 + 64 * (j))
#define XB_XGEN(j)  (2304 + 64 * (j))
#define XB_TOP      3328
#define XB_TOPGEN   3392
#define XCD_BAR_WORDS 3456
#define XB_SPIN_CAP (1u << 18)

__device__ __forceinline__ unsigned xb_ld(unsigned* p)              { return __hip_atomic_load(p, __ATOMIC_RELAXED, __HIP_MEMORY_SCOPE_AGENT); }
__device__ __forceinline__ unsigned xb_add(unsigned* p, unsigned v) { return __hip_atomic_fetch_add(p, v, __ATOMIC_RELAXED, __HIP_MEMORY_SCOPE_AGENT); }
__device__ __forceinline__ unsigned xb_xcc_id() { return (unsigned)__builtin_amdgcn_s_getreg((3 << 11) | 20) & 0xFu; }
#define XB_SPIN(cond, bar) do { unsigned _sp = 0; while (cond) { __builtin_amdgcn_s_sleep(1); \
    if ((++_sp & 255u) == 0u) { if (xb_ld(&(bar)[XB_TMO])) break; if (_sp > XB_SPIN_CAP) { atomicAdd(&(bar)[XB_TMO], 1u); break; } } } } while (0)

struct XcdBarrier {
    unsigned* bar; unsigned x;
    volatile LAS unsigned* st;
};

__device__ __forceinline__ XcdBarrier xcd_barrier_post(unsigned* bar, volatile LAS unsigned* st) {
    XcdBarrier b; b.bar = bar; b.x = xb_xcc_id(); b.st = st;
    if (threadIdx.x == 0) (void)xb_add(&bar[XB_XCNT(b.x)], 1u);
    return b;
}
__device__ __forceinline__ void xcd_barrier_complete(unsigned* bar, unsigned x, unsigned& nloc, unsigned& nx) {
    const unsigned G = gridDim.x * gridDim.y * gridDim.z;
    unsigned sum, cnt, mine, sp = 0u;
    for (;;) {
        sum = 0u; cnt = 0u; mine = 0u;
#pragma unroll
        for (unsigned j = 0; j < 16; ++j) { const unsigned c = xb_ld(&bar[XB_XCNT(j)]); sum += c; cnt += (c > 0u) ? 1u : 0u; mine = (j == x) ? c : mine; }
        if (sum == G) break;
        __builtin_amdgcn_s_sleep(1);
        if ((++sp & 255u) == 0u) { if (xb_ld(&bar[XB_TMO])) break; if (sp > XB_SPIN_CAP) { atomicAdd(&bar[XB_TMO], 1u); break; } }
    }
    nloc = mine > 0u ? mine : 1u; nx = cnt > 0u ? cnt : 1u;
}

__device__ __forceinline__ void xcd_barrier(const XcdBarrier& b) {
    asm volatile("s_waitcnt vmcnt(0)" ::: "memory");
    __syncthreads();
    if (threadIdx.x == 0) {
        unsigned* bar = b.bar;
        __builtin_amdgcn_s_waitcnt(0);
        unsigned nloc = b.st[0], nx = b.st[1];
        if (nloc == 0u) { xcd_barrier_complete(bar, b.x, nloc, nx); b.st[0] = nloc; b.st[1] = nx; }
        const unsigned old = xb_add(&bar[XB_XSUB(b.x)], 1u);
        const unsigned gen = old / nloc;
        if (old + 1u == (gen + 1u) * nloc) {
            __builtin_amdgcn_fence(__ATOMIC_RELEASE, "agent");
            asm volatile("s_waitcnt vmcnt(0)" ::: "memory");
            const unsigned og = xb_add(&bar[XB_TOP], 1u);
            const unsigned tg = og / nx;
            if (og + 1u == (tg + 1u) * nx) xb_add(&bar[XB_TOPGEN], 1u);
            else XB_SPIN(xb_ld(&bar[XB_TOPGEN]) == tg, bar);
            __builtin_amdgcn_fence(__ATOMIC_ACQUIRE, "agent");
            xb_add(&bar[XB_XGEN(b.x)], 1u);
            asm volatile("s_waitcnt vmcnt(0)" ::: "memory");
        } else {
            XB_SPIN(xb_ld(&bar[XB_XGEN(b.x)]) == gen, bar);
            __builtin_amdgcn_fence(__ATOMIC_ACQUIRE, "agent");
            asm volatile("s_waitcnt vmcnt(0)" ::: "memory");
        }
    }
    __syncthreads();
}

__global__ void __launch_bounds__(NTHR, 2) fwd_megakernel(Args a) {
    extern __shared__ __attribute__((aligned(16))) unsigned char lds_raw[];
    cg::grid_group grid = cg::this_grid();
    LAS unsigned char* lds = (LAS unsigned char*)lds_raw;
    const int G = gridDim.x, cu = blockIdx.x, NGW = G * NWAVES;
    volatile LAS unsigned* MISC = (volatile LAS unsigned*)(lds + 131072);
    if (threadIdx.x < 64) MISC[threadIdx.x] = 0u;
    __syncthreads();
    (void)xcd_barrier_post((unsigned*)(a.ws + WS_CTL), MISC + 8);
#define GRID_BAR() do { XcdBarrier bar_; bar_.bar = (unsigned*)(ws + WS_CTL); bar_.x = xb_xcc_id(); bar_.st = (volatile LAS unsigned*)(lds + 131072) + 8; xcd_barrier(bar_); } while (0)
    {
        int tid = threadIdx.x; asm volatile("" : "+v"(tid));
        size_t wsoff = 0; asm volatile("" : "+s"(wsoff)); unsigned char* ws = a.ws + wsoff;
        const int lane = tid & 63, wave = __builtin_amdgcn_readfirstlane(tid >> 6), gw = cu * NWAVES + wave;
        prologue(a, lds, G, tid, ws);
        asm volatile("s_waitcnt vmcnt(0)" ::: "memory"); __syncthreads();
        grid.sync();
        __builtin_amdgcn_fence(__ATOMIC_ACQUIRE, "agent"); asm volatile("s_waitcnt vmcnt(0)" ::: "memory"); __syncthreads();
        ew_phase(true, false, a.in[0], a.in[1], a.out, nullptr, nullptr, 0, 0.f, nullptr, (const float*)(ws + WS_SMALL), (const float*)(ws + WS_MOD), 0, (bf16_t*)(ws + WS_H), gw, NGW, lane);
    }
    constexpr int NPH = 2 + 11 * NL;
    for (int ph = 1; ph < NPH; ++ph) {
        const int q = ph - 2, l = ph < 2 ? 0 : q / 11, k = ph < 2 ? -1 : q % 11, jl = l >> 1; const bool four = (l & 1) == 0;
        bool sync_after = ph != NPH - 1;
        int tid = threadIdx.x; asm volatile("" : "+v"(tid));
        size_t wsoff = 0; asm volatile("" : "+s"(wsoff)); unsigned char* ws = a.ws + wsoff;
        const int lane = tid & 63, wave = __builtin_amdgcn_readfirstlane(tid >> 6), gw = cu * NWAVES + wave;
        const float* npre = (const float*)(ws + WS_SMALL); const float* npost = npre + 12288;
        if (k == 2 || k == 7 || k == 10) {
            const float* modl = (const float*)(ws + WS_MOD) + (size_t)l * 3 * 9216;
            const int kk = k == 2 ? 0 : (k == 7 ? 1 : 2); const bool last = (k == 10 && l == NL - 1);
            const float* gpre = k == 10 ? npre + ((l + 1) * 3) * D : npre + (l * 3 + kk + 1) * D;
            ew_phase(false, last, nullptr, nullptr, a.out, (const bf16_t*)(ws + WS_Y), modl, 3 * kk + 2, kk == 1 ? 1.0f : 0.5f, npost + (l * 3 + kk) * D, gpre, k == 10 ? modl + 3 * 9216 : modl, k == 10 ? 0 : 3 * kk + 3,
                     (bf16_t*)(ws + WS_H), gw, NGW, lane);
        } else if (k == 4 && !four) {
            attn_phase(lds, (const bf16_t*)(ws + WS_MIX), (const bf16_t*)(ws + WS_MIX + 24 * MiB), (const bf16_t*)(ws + WS_MIX + 48 * MiB), (const bf16_t*)(ws + WS_CK), (const bf16_t*)(ws + WS_CVT),
                       npre + 24576 + (size_t)jl * 16 * 15 * 31, (bf16_t*)(ws + WS_MIX + 72 * MiB), jl, cu, G, tid);
        } else if (k == 5 && !four) {
            sync_after = false;
        } else {
            const bf16_t *A, *Bt; int M = T, N = 1024, K = 1024, nZ = 1, kind = EK_Y; unsigned zAl = 0, zBh = 0, zBl = 0;
            if (k == -1) { A = (const bf16_t*)(ws + WS_CST); Bt = (const bf16_t*)(ws + WS_WINB); M = 2048; nZ = 2; zBl = 1024u * 1024u * 2u; kind = EK_FOLD; }
            else if (k == 0 || k == 8) { A = (const bf16_t*)(ws + WS_H); Bt = (const bf16_t*)(ws + WS_W1T) + (size_t)(l * 2 + (k == 8)) * 5632 * 1024; N = 5632; kind = EK_SWIGLU; }
            else if (k == 1 || k == 9) { A = (const bf16_t*)(ws + WS_A); Bt = (const bf16_t*)(ws + WS_W2T) + (size_t)(l * 2 + (k == 9)) * 1024 * FF; K = FF; }
            else if (k == 3) {
                if (four) { A = (const bf16_t*)(ws + WS_FINT) + (size_t)jl * 2048 * 1024; Bt = (const bf16_t*)(ws + WS_H); M = 2048; N = T; kind = EK_UT; }
                else { A = (const bf16_t*)(ws + WS_H); Bt = (const bf16_t*)(ws + WS_WQKVT) + (size_t)jl * 3072 * 1024; N = 3072; kind = EK_QKV; }
            } else if (k == 4) { A = (const bf16_t*)(ws + WS_DFTP); Bt = (const bf16_t*)(ws + WS_MIX); M = 256; K = 256; nZ = 32; zAl = 256u * 256u * 2u; zBh = 2048u * 256u * 2u; zBl = 1024u * 256u * 2u; kind = EK_POSP; sync_after = false; }
            else if (k == 5) { A = (const bf16_t*)(ws + WS_DFTS); Bt = (const bf16_t*)(ws + WS_MIX) + (size_t)16 * 2048 * 256; M = 4096; K = 4096; nZ = 4; zAl = 4096u * 4096u * 2u; zBh = 2048u * 4096u * 2u; zBl = 1024u * 4096u * 2u; kind = EK_POSS; }
            else {
                if (four) { A = (const bf16_t*)(ws + WS_MIX + 48 * MiB); Bt = (const bf16_t*)(ws + WS_FOUTT) + (size_t)jl * 1024 * 2048; K = 2048; }
                else { A = (const bf16_t*)(ws + WS_MIX + 72 * MiB); Bt = (const bf16_t*)(ws + WS_WOT) + (size_t)jl * 1024 * 1024; }
            }
            pg8::Gemm g{A, Bt, M, N, K}; Order S; S.init(M, N, K, nZ, G, cu, zAl, zBh, zBl);
            EpiMulti E{kind, jl, ws, a.out}; pg8::gemm_phase<EpiMulti, Order, true, true>(lds, g, S, E);
        }
        if (sync_after) GRID_BAR();
    }
}

extern "C" void kernel_launch(void* const* d_in, const int* in_sizes, int n_in, void* d_out, int out_size, void* d_ws, size_t ws_size, hipStream_t stream) {
    static int grid = 0;
    if (grid == 0) {
        if (n_in != 17 || ws_size < WS_END) { fprintf(stderr, "kernel_launch: unexpected n_in %d or ws_size %zu\n", n_in, ws_size); grid = -1; return; }
        int dev = 0, cus = 0, per_cu = 0;
        hipGetDevice(&dev); hipDeviceGetAttribute(&cus, hipDeviceAttributeMultiprocessorCount, dev);
        hipFuncSetAttribute((const void*)fwd_megakernel, hipFuncAttributeMaxDynamicSharedMemorySize, LDS_BYTES);
        hipOccupancyMaxActiveBlocksPerMultiprocessor(&per_cu, (const void*)fwd_megakernel, NTHR, LDS_BYTES);
        if (per_cu < 1) { fprintf(stderr, "kernel_launch: occupancy query says %d blocks per CU\n", per_cu); per_cu = 1; }
        (void)hipGetLastError();
        grid = cus;
    }
    if (grid < 0) return;
    if (hipMemsetAsync((char*)d_ws + WS_CTL, 0, CTL_BYTES, stream) != hipSuccess) { fprintf(stderr, "kernel_launch: memset failed\n"); return; }
    Args a{};
    for (int i = 0; i < 17; ++i) a.in[i] = (const float*)d_in[i];
    a.out = (float*)d_out; a.ws = (unsigned char*)d_ws;
    void* args[] = {&a};
    hipError_t e = hipLaunchCooperativeKernel((const void*)fwd_megakernel, dim3(grid), dim3(NTHR), args, LDS_BYTES, stream);
    if (e != hipSuccess) fprintf(stderr, "cooperative launch failed: %s (grid %d)\n", hipGetErrorString(e), grid);
}
```
